# Optimizing an MI355X kernel written in HIP

```python
import math
import jax, jax.numpy as jnp
from jax import lax
import numpy as np

D_MODEL = 2048
BATCH = 4
SEQ = 2048
DEPTH = 4

MEM_LEN = 256
EPS = 1e-5

SG_CHUNK = 128
N_SG = 4
D_SG = 512
SG_GROUP = D_SG // N_SG

N_MLA = 4
MLA_Q_RANK = 384
MLA_KV_RANK = 256
MLA_NOPE = 128
MLA_ROPE = 64
MLA_V = 128
ROPE_BASE = 10000.0
Q_BLOCK = 128

N_GLA = 4
GLA_DK = 64
GLA_DV = 128
GLA_GATE_RANK = 16
GLA_TAU = 16.0
GLA_CHUNK = 64
GLA_QK = N_GLA * GLA_DK
GLA_VW = N_GLA * GLA_DV

N_ML = 4
ML_DK = 64
ML_DV = 128
ML_CONV = 4
ML_CHUNK = 64
ML_QK = N_ML * ML_DK
ML_VW = N_ML * ML_DV

N_BRANCH = 4
BRANCH_W = 512

N_X = 4
X_HEAD = 128

N_EXPERTS = 16
N_GROUPS = 4
TOP_K = 2
D_EXPERT = 512

SG_IN = 2 * D_SG
MLA_IN = MLA_Q_RANK + MLA_KV_RANK + MLA_ROPE
GLA_IN = 2 * GLA_QK + 2 * GLA_VW + GLA_GATE_RANK
ML_IN = 2 * ML_QK + 2 * ML_VW + 2 * N_ML
GATE_IN = N_BRANCH * D_MODEL
IN_SPLITS = (SG_IN, MLA_IN, GLA_IN, ML_IN, GATE_IN)
D_IN = SG_IN + MLA_IN + GLA_IN + ML_IN + GATE_IN

kernel_name = "hybrid_gated_mixer_deepnorm_moe"


def _split(x, sizes):
    out, off = [], 0
    for s in sizes:
        out.append(x[..., off:off + s])
        off += s
    return out


def layer_norm(x, g, b):
    xf = x.astype(jnp.float32)
    mu = jnp.mean(xf, -1, keepdims=True)
    var = jnp.mean(jnp.square(xf - mu), -1, keepdims=True)
    y = (xf - mu) * lax.rsqrt(var + EPS) * g.astype(jnp.float32) + b.astype(jnp.float32)
    return y.astype(x.dtype)


def rms_norm(x, g):
    xf = x.astype(jnp.float32)
    y = xf * lax.rsqrt(jnp.mean(xf * xf, -1, keepdims=True) + EPS) * g.astype(jnp.float32)
    return y.astype(x.dtype)


def rope(x, pos):
    half = x.shape[-1] // 2
    freqs = ROPE_BASE ** (-jnp.arange(half, dtype=jnp.float32) / half)
    ang = pos.astype(jnp.float32)[..., None] * freqs
    cos, sin = jnp.cos(ang)[:, :, None, :], jnp.sin(ang)[:, :, None, :]
    xf = x.astype(jnp.float32)
    x1, x2 = xf[..., :half], xf[..., half:]
    return jnp.concatenate([x1 * cos - x2 * sin, x1 * sin + x2 * cos], -1).astype(x.dtype)


def spatial_gating(z, v_g, v_b, w_s, b_s):
    B, S, _ = z.shape
    u, v = z[..., :D_SG], z[..., D_SG:]
    v = layer_norm(v, v_g, v_b).reshape(B, S // SG_CHUNK, SG_CHUNK, N_SG, SG_GROUP)
    causal = jnp.tril(jnp.ones((SG_CHUNK, SG_CHUNK), dtype=bool))
    w = jnp.where(causal, w_s, 0.0).astype(v.dtype)
    mixed = jnp.einsum('gts,bcsgd->bctgd', w, v) + b_s.T[:, :, None]
    return u * mixed.reshape(B, S, D_SG)


def causal_block_attention(q, k, v, scale):
    B, S, H, Dq = q.shape
    nb = S // Q_BLOCK
    qb = q.reshape(B, nb, Q_BLOCK, H, Dq).transpose(1, 0, 2, 3, 4)
    k_idx = jnp.arange(S)

    def one_block(args):
        q_blk, i = args
        s = jnp.einsum('bthd,bshd->bhts', q_blk, k).astype(jnp.float32) * scale
        q_idx = i * Q_BLOCK + jnp.arange(Q_BLOCK)
        s = jnp.where(k_idx[None, :] <= q_idx[:, None], s, -jnp.inf)
        p = jax.nn.softmax(s, axis=-1).astype(v.dtype)
        return jnp.einsum('bhts,bshd->bthd', p, v)

    out = lax.map(one_block, (qb, jnp.arange(nb)))
    return out.transpose(1, 0, 2, 3, 4).reshape(B, S, H * v.shape[-1])


def mla_attention(c_q, c_kv, k_rope, pos, q_g, kv_g, w_uq, w_ukv):
    B, S, _ = c_q.shape
    q = (rms_norm(c_q, q_g) @ w_uq).reshape(B, S, N_MLA, MLA_NOPE + MLA_ROPE)
    kv = (rms_norm(c_kv, kv_g) @ w_ukv).reshape(B, S, N_MLA, MLA_NOPE + MLA_V)
    q = jnp.concatenate([q[..., :MLA_NOPE], rope(q[..., MLA_NOPE:], pos)], -1)
    k_r = jnp.broadcast_to(rope(k_rope[:, :, None, :], pos), (B, S, N_MLA, MLA_ROPE))
    k = jnp.concatenate([kv[..., :MLA_NOPE], k_r], -1)
    v = kv[..., MLA_NOPE:]
    return causal_block_attention(q, k, v, (MLA_NOPE + MLA_ROPE) ** -0.5)


def gla(q, k, v, o_gate, gate_lr, w_gate, b_gate, norm_g):
    B, S, _ = q.shape
    L, nc = GLA_CHUNK, S // GLA_CHUNK
    log_a = jax.nn.log_sigmoid((gate_lr @ w_gate + b_gate).astype(jnp.float32)) / GLA_TAU

    def chunks(t, d):
        return t.reshape(B, nc, L, N_GLA, d).transpose(1, 0, 3, 2, 4).astype(jnp.float32)

    qc = chunks(q, GLA_DK) * (GLA_DK ** -0.5)
    kc, vc, ac = chunks(k, GLA_DK), chunks(v, GLA_DV), chunks(log_a, GLA_DK)
    causal = jnp.tril(jnp.ones((L, L), dtype=bool))

    def step(state, inp):
        qi, ki, vi, ai = inp
        b = jnp.cumsum(ai, axis=2)
        b_last = b[:, :, -1:, :]
        q_t = qi * jnp.exp(b)
        att = jnp.where(causal, jnp.einsum('bhtd,bhsd->bhts', q_t, ki * jnp.exp(-b)), 0.0)
        o = jnp.einsum('bhts,bhsv->bhtv', att, vi) + jnp.einsum('bhtd,bhdv->bhtv', q_t, state)
        state = state * jnp.exp(b_last[:, :, 0, :])[..., None] + \
            jnp.einsum('bhsd,bhsv->bhdv', ki * jnp.exp(b_last - b), vi)
        return state, o

    init = jnp.zeros((B, N_GLA, GLA_DK, GLA_DV), jnp.float32)
    _, o = lax.scan(step, init, (qc, kc, vc, ac))
    o = rms_norm(o.transpose(1, 0, 3, 2, 4).reshape(B, S, N_GLA, GLA_DV), norm_g)
    return (o.reshape(B, S, GLA_VW) * jax.nn.silu(o_gate.astype(jnp.float32))).astype(v.dtype)


def causal_depthwise_conv(x, w, b):
    K, C = w.shape
    y = lax.conv_general_dilated(x, w[:, None, :], window_strides=(1,), padding=[(K - 1, 0)],
                                 dimension_numbers=('NWC', 'WIO', 'NWC'), feature_group_count=C)
    return y + b


def mlstm(q, k, v, o_pre, i_pre, f_pre, norm_g):
    B, S, _ = q.shape
    L, nc = ML_CHUNK, S // ML_CHUNK

    def chunks(t, d):
        return t.reshape(B, nc, L, N_ML, d).transpose(1, 0, 3, 2, 4).astype(jnp.float32)

    def gchunks(t):
        return t.reshape(B, nc, L, N_ML).transpose(1, 0, 3, 2).astype(jnp.float32)

    qc = chunks(q, ML_DK) * (ML_DK ** -0.5)
    kc, vc = chunks(k, ML_DK), chunks(v, ML_DV)
    fc = gchunks(jax.nn.log_sigmoid(f_pre.astype(jnp.float32)))
    ic = gchunks(i_pre)
    causal = jnp.tril(jnp.ones((L, L), dtype=bool))

    def step(carry, inp):
        C, n, m = carry
        qi, ki, vi, fi, ii = inp
        b = jnp.cumsum(fi, axis=-1)
        log_inter = b + m[..., None]
        log_d = jnp.where(causal, b[..., :, None] - b[..., None, :] + ii[..., None, :], -jnp.inf)
        m_t = jnp.maximum(log_inter, jnp.max(log_d, -1))
        w_inter = jnp.exp(log_inter - m_t)
        s = jnp.einsum('bhtd,bhsd->bhts', qi, ki) * jnp.exp(log_d - m_t[..., None])
        num = jnp.einsum('bhts,bhsv->bhtv', s, vi) + \
            w_inter[..., None] * jnp.einsum('bhtd,bhdv->bhtv', qi, C)
        den = jnp.sum(s, -1) + w_inter * jnp.einsum('bhtd,bhd->bht', qi, n)
        h = num / jnp.maximum(jnp.abs(den), jnp.exp(-m_t))[..., None]
        b_last = b[..., -1]
        log_w = b_last[..., None] - b + ii
        m_new = jnp.maximum(b_last + m, jnp.max(log_w, -1))
        decay = jnp.exp(b_last + m - m_new)
        w = jnp.exp(log_w - m_new[..., None])
        C = decay[..., None, None] * C + jnp.einsum('bhs,bhsd,bhsv->bhdv', w, ki, vi)
        n = decay[..., None] * n + jnp.einsum('bhs,bhsd->bhd', w, ki)
        return (C, n, m_new), h

    init = (jnp.zeros((B, N_ML, ML_DK, ML_DV), jnp.float32),
            jnp.zeros((B, N_ML, ML_DK), jnp.float32),
            jnp.zeros((B, N_ML), jnp.float32))
    _, h = lax.scan(step, init, (qc, kc, vc, fc, ic))
    h = rms_norm(h.transpose(1, 0, 3, 2, 4).reshape(B, S, N_ML, ML_DV), norm_g)
    return (h.reshape(B, S, ML_VW) * jax.nn.sigmoid(o_pre.astype(jnp.float32))).astype(v.dtype)


def hybrid_mixer(h, positions, w_in, sg_vnorm_g, sg_vnorm_b, sg_w_s, sg_b_s,
                 mla_qnorm_g, mla_kvnorm_g, mla_w_uq, mla_w_ukv,
                 gla_w_gate, gla_b_gate, gla_norm_g,
                 ml_conv_w, ml_conv_b, ml_gate_b, ml_norm_g, w_branch, w_out):
    B, S, D = h.shape
    z_sg, z_mla, z_gla, z_ml, z_gate = _split(h @ w_in, IN_SPLITS)
    y_a = spatial_gating(jax.nn.gelu(z_sg), sg_vnorm_g, sg_vnorm_b, sg_w_s, sg_b_s)
    c_q, c_kv, k_rope = _split(z_mla, (MLA_Q_RANK, MLA_KV_RANK, MLA_ROPE))
    y_b = mla_attention(c_q, c_kv, k_rope, positions, mla_qnorm_g, mla_kvnorm_g, mla_w_uq, mla_w_ukv)
    g_q, g_k, g_v, g_o, g_lr = _split(z_gla, (GLA_QK, GLA_QK, GLA_VW, GLA_VW, GLA_GATE_RANK))
    y_c = gla(g_q, g_k, g_v, g_o, g_lr, gla_w_gate, gla_b_gate, gla_norm_g)
    m_qk, m_v, m_o, m_if = _split(z_ml, (2 * ML_QK, ML_VW, ML_VW, 2 * N_ML))
    m_q, m_k = _split(jax.nn.silu(causal_depthwise_conv(m_qk, ml_conv_w, ml_conv_b)), (ML_QK, ML_QK))
    m_i, m_f = _split(m_if + ml_gate_b, (N_ML, N_ML))
    y_d = mlstm(m_q, m_k, m_v, m_o, m_i, m_f, ml_norm_g)
    branches = jnp.stack([y_a, y_b, y_c, y_d], axis=2)
    gates = jax.nn.sigmoid(z_gate).reshape(B, S, N_BRANCH, D)
    merged = jnp.einsum('bsnd,bsnd->bsd', gates, jnp.einsum('bsnw,nwd->bsnd', branches, w_branch))
    return merged @ w_out


def memory_cross_attention(h, mem, w_q, w_kv, w_o):
    B, S, _ = h.shape
    M = mem.shape[1]
    q = (h @ w_q).reshape(B, S, N_X, X_HEAD)
    kv = (mem @ w_kv).reshape(B, M, 2, N_X, X_HEAD)
    s = jnp.einsum('bthd,bshd->bhts', q, kv[:, :, 0]).astype(jnp.float32) * (X_HEAD ** -0.5)
    p = jax.nn.softmax(s, axis=-1).astype(h.dtype)
    o = jnp.einsum('bhts,bshd->bthd', p, kv[:, :, 1]).reshape(B, S, N_X * X_HEAD)
    return o @ w_o


def grouped_moe(h, w_router, router_bias, w_gate, w_up, w_down):
    B, S, D = h.shape
    t = h.reshape(B * S, D)
    aff = jax.nn.sigmoid((t @ w_router).astype(jnp.float32))
    per_group = N_EXPERTS // N_GROUPS
    biased = (aff + router_bias.astype(jnp.float32)).reshape(-1, N_GROUPS, per_group)
    group_score = lax.top_k(biased, TOP_K)[0].sum(-1)
    g_idx = jnp.argmax(group_score, axis=-1)
    in_group = jnp.take_along_axis(biased, g_idx[:, None, None], axis=1)[:, 0]
    _, local = lax.top_k(in_group, TOP_K)
    exp_idx = g_idx[:, None] * per_group + local
    sel = jnp.take_along_axis(aff, exp_idx, axis=1)
    wts = sel / jnp.sum(sel, -1, keepdims=True)
    gates = jnp.sum(jax.nn.one_hot(exp_idx, N_EXPERTS, dtype=jnp.float32) * wts[..., None], axis=1)
    hid = jax.nn.silu(jnp.einsum('nd,edf->nef', t, w_gate)) * jnp.einsum('nd,edf->nef', t, w_up)
    hid = hid * gates.astype(hid.dtype)[..., None]
    return jnp.einsum('nef,efd->nd', hid, w_down).reshape(B, S, D)


def setup_inputs(seed: int = 0) -> dict:
    key = jax.random.key(seed)
    ks = iter(jax.random.split(key, 48))
    f32 = jnp.float32

    def nrm(shape, scale):
        return jax.random.normal(next(ks), shape, f32) * scale

    Ld, D = DEPTH, D_MODEL
    beta = (8.0 * DEPTH) ** -0.25
    x = nrm((BATCH, SEQ, D), 1.0)
    mem = nrm((BATCH, MEM_LEN, D), 1.0)
    positions = jax.random.randint(next(ks), (BATCH, 1), 0, 4096, dtype=jnp.int32) + \
        jnp.arange(SEQ, dtype=jnp.int32)[None, :]
    return {
        "x": x,
        "mem": mem,
        "positions": positions,
        "ln_in_g": 1.0 + nrm((D,), 0.05),
        "ln_in_b": nrm((D,), 0.02),
        "w_in": nrm((Ld, D, D_IN), D ** -0.5),
        "sg_vnorm_g": 1.0 + nrm((Ld, D_SG), 0.05),
        "sg_vnorm_b": nrm((Ld, D_SG), 0.02),
        "sg_w_s": nrm((Ld, N_SG, SG_CHUNK, SG_CHUNK), 0.5 * SG_CHUNK ** -0.5),
        "sg_b_s": 1.0 + nrm((Ld, N_SG, SG_CHUNK), 0.1),
        "mla_qnorm_g": 1.0 + nrm((Ld, MLA_Q_RANK), 0.05),
        "mla_kvnorm_g": 1.0 + nrm((Ld, MLA_KV_RANK), 0.05),
        "mla_w_uq": nrm((Ld, MLA_Q_RANK, N_MLA * (MLA_NOPE + MLA_ROPE)), MLA_Q_RANK ** -0.5),
        "mla_w_ukv": nrm((Ld, MLA_KV_RANK, N_MLA * (MLA_NOPE + MLA_V)), MLA_KV_RANK ** -0.5),
        "gla_w_gate": nrm((Ld, GLA_GATE_RANK, GLA_QK), GLA_GATE_RANK ** -0.5),
        "gla_b_gate": nrm((Ld, GLA_QK), 0.1),
        "gla_norm_g": 1.0 + nrm((Ld, GLA_DV), 0.05),
        "ml_conv_w": nrm((Ld, ML_CONV, 2 * ML_QK), ML_CONV ** -0.5),
        "ml_conv_b": nrm((Ld, 2 * ML_QK), 0.02),
        "ml_gate_b": jnp.concatenate(
            [nrm((Ld, N_ML), 0.1),
             jnp.broadcast_to(jnp.linspace(3.0, 6.0, N_ML, dtype=f32), (Ld, N_ML)) + nrm((Ld, N_ML), 0.1)],
            axis=-1),
        "ml_norm_g": 1.0 + nrm((Ld, ML_DV), 0.05),
        "w_branch": nrm((Ld, N_BRANCH, BRANCH_W, D), beta * BRANCH_W ** -0.5),
        "w_out": nrm((Ld, D, D), beta * D ** -0.5),
        "ln1_g": 1.0 + nrm((Ld, D), 0.05),
        "ln1_b": nrm((Ld, D), 0.02),
        "x_w_q": nrm((Ld, D, N_X * X_HEAD), D ** -0.5),
        "x_w_kv": nrm((Ld, D, 2 * N_X * X_HEAD), D ** -0.5),
        "x_w_o": nrm((Ld, N_X * X_HEAD, D), beta * (N_X * X_HEAD) ** -0.5),
        "ln2_g": 1.0 + nrm((Ld, D), 0.05),
        "ln2_b": nrm((Ld, D), 0.02),
        "w_router": nrm((D, N_EXPERTS), D ** -0.5),
        "router_bias": nrm((N_EXPERTS,), 0.01),
        "moe_w_gate": nrm((Ld, N_EXPERTS, D, D_EXPERT), D ** -0.5),
        "moe_w_up": nrm((Ld, N_EXPERTS, D, D_EXPERT), D ** -0.5),
        "moe_w_down": nrm((Ld, N_EXPERTS, D_EXPERT, D), beta * D_EXPERT ** -0.5),
        "ln3_g": 1.0 + nrm((Ld, D), 0.05),
        "ln3_b": nrm((Ld, D), 0.02),
    }


def reference(x, mem, positions, ln_in_g, ln_in_b, w_in, sg_vnorm_g, sg_vnorm_b, sg_w_s, sg_b_s,
              mla_qnorm_g, mla_kvnorm_g, mla_w_uq, mla_w_ukv, gla_w_gate, gla_b_gate, gla_norm_g,
              ml_conv_w, ml_conv_b, ml_gate_b, ml_norm_g, w_branch, w_out, ln1_g, ln1_b,
              x_w_q, x_w_kv, x_w_o, ln2_g, ln2_b, w_router, router_bias,
              moe_w_gate, moe_w_up, moe_w_down, ln3_g, ln3_b):
    alpha = (2.0 * DEPTH) ** 0.25
    h = layer_norm(x, ln_in_g, ln_in_b)
    for l in range(DEPTH):
        y = hybrid_mixer(h, positions, w_in[l], sg_vnorm_g[l], sg_vnorm_b[l], sg_w_s[l], sg_b_s[l],
                         mla_qnorm_g[l], mla_kvnorm_g[l], mla_w_uq[l], mla_w_ukv[l],
                         gla_w_gate[l], gla_b_gate[l], gla_norm_g[l],
                         ml_conv_w[l], ml_conv_b[l], ml_gate_b[l], ml_norm_g[l], w_branch[l], w_out[l])
        h = layer_norm(alpha * h + y, ln1_g[l], ln1_b[l])
        y = memory_cross_attention(h, mem, x_w_q[l], x_w_kv[l], x_w_o[l])
        h = layer_norm(alpha * h + y, ln2_g[l], ln2_b[l])
        y = grouped_moe(h, w_router, router_bias, moe_w_gate[l], moe_w_up[l], moe_w_down[l])
        h = layer_norm(alpha * h + y, ln3_g[l], ln3_b[l])
    return h
```

```cpp
#include <hip/hip_runtime.h>
#include <cstdio>
#include <cstdint>

#ifndef REP_MASK
#define REP_MASK 0u
#endif
#ifndef MK_MULTI
#define MK_MULTI 0
#endif

#define LAS __attribute__((address_space(3)))
#define GAS __attribute__((address_space(1)))
typedef unsigned short bf16_t;
typedef short bf16x8 __attribute__((ext_vector_type(8)));
typedef short s16x4 __attribute__((ext_vector_type(4)));
typedef float f32x4 __attribute__((ext_vector_type(4)));
typedef float f32x2 __attribute__((ext_vector_type(2)));
typedef unsigned u32x4 __attribute__((ext_vector_type(4)));
typedef unsigned u32x2 __attribute__((ext_vector_type(2)));
typedef int v4i_t __attribute__((ext_vector_type(4)));
typedef int v8i_t __attribute__((ext_vector_type(8)));
typedef GAS unsigned gu32;

constexpr int NT = 8192, DM = 2048, SEQ = 2048, NB = 4, DEPTH = 4, MEMLEN = 256, NMEM = NB * MEMLEN;
constexpr int DIN = 13016, ZLD = 13056;
constexpr int Z_SGU = 0, Z_SGV = 512, Z_GQ = 1024, Z_GK = 1280, Z_GV = 1536, Z_GO = 2048, Z_MQK = 2560, Z_MV = 3072, Z_MO = 3584, Z_GATE = 4096,
              Z_CQ = 12288, Z_CKV = 12672, Z_KR = 12928, Z_LR = 12992, Z_IF = 13008;
constexpr float LN_EPS = 1e-5f;
constexpr float ALPHA = 1.681792830507429f;
constexpr float LOG2E = 1.4426950408889634f;
constexpr int XG_ROWS = 20480;
constexpr int NWAVES = 8, NTHREADS = 512;

constexpr size_t MiB = 1u << 20;
constexpr size_t WS_CTL = 0, CTL_ZERO_BYTES = 1 * MiB;
constexpr size_t WS_WIN = 1 * MiB;
constexpr size_t WS_WUQ = WS_WIN + 52 * MiB;
constexpr size_t WS_WUKV = WS_WUQ + 1 * MiB;
constexpr size_t WS_WBR = WS_WUKV + 1 * MiB;
constexpr size_t WS_WOUT = WS_WBR + 8 * MiB;
constexpr size_t WS_WXQ = WS_WOUT + 8 * MiB;
constexpr size_t WS_WXKV = WS_WXQ + 2 * MiB;
constexpr size_t WS_WXO = WS_WXKV + 4 * MiB;
constexpr size_t WS_WGU = WS_WXO + 2 * MiB;
constexpr size_t WS_WD = WS_WGU + 64 * MiB;
constexpr size_t WS_WG8 = WS_WD + 32 * MiB;
constexpr size_t WS_HF = WS_WG8 + 16 * MiB;
constexpr size_t WS_HB = WS_HF + 64 * MiB;
constexpr size_t WS_Z = WS_HB + 32 * MiB;
constexpr size_t WS_VN = WS_Z + 204 * MiB;
constexpr size_t WS_CQN = WS_VN + 8 * MiB;
constexpr size_t WS_CKVN = WS_CQN + 6 * MiB;
constexpr size_t WS_KR = WS_CKVN + 4 * MiB;
constexpr size_t WS_CS = WS_KR + 1 * MiB;
constexpr size_t WS_LOGA = WS_CS + 2 * MiB;
constexpr size_t WS_MQ = WS_LOGA + 8 * MiB;
constexpr size_t WS_MK = WS_MQ + 4 * MiB;
constexpr size_t WS_GIF = WS_MK + 4 * MiB;
constexpr size_t WS_Q = WS_GIF + 1 * MiB;
constexpr size_t WS_KN = WS_Q + 12 * MiB;
constexpr size_t WS_V = WS_KN + 8 * MiB;
constexpr size_t WS_UG = WS_V + 8 * MiB;
constexpr size_t WS_DEC = WS_UG + 16 * MiB;
constexpr size_t WS_SG = WS_DEC + 1 * MiB;
constexpr size_t WS_UM = WS_SG + 8 * MiB;
constexpr size_t WS_CG = WS_UM + 18 * MiB;
constexpr size_t WS_MSC = WS_CG + 9 * MiB;
constexpr size_t WS_YCAT = WS_MSC + 1 * MiB;
constexpr size_t WS_MRG = WS_YCAT + 32 * MiB;
constexpr size_t WS_MEMB = WS_MRG + 32 * MiB;
constexpr size_t WS_XQ = WS_MEMB + 4 * MiB;
constexpr size_t WS_XKV = WS_XQ + 8 * MiB;
constexpr size_t WS_XO = WS_XKV + 2 * MiB;
constexpr size_t WS_TOK = WS_XO + 8 * MiB;
constexpr size_t WS_ROWW = WS_TOK + 1 * MiB;
constexpr size_t WS_XG = WS_ROWW + 1 * MiB;
constexpr size_t WS_HID = WS_XG + 80 * MiB;
constexpr size_t WS_YD = WS_HID + 20 * MiB;
constexpr size_t WS_WRT = WS_YD + 80 * MiB;
constexpr size_t WS_XQP = WS_WRT + 1 * MiB;
constexpr size_t WS_GQ = WS_XQP + 64 * MiB;
constexpr size_t WS_HT = WS_GQ + 64 * MiB;
constexpr size_t WS_LNX = WS_HT + 64 * MiB;
constexpr size_t WS_HB8 = WS_LNX + 4 * MiB;
constexpr size_t WS_YC8 = WS_HB8 + 16 * MiB;
constexpr size_t WS_ENDX = WS_YC8 + 16 * MiB;
constexpr size_t WS_SET1_DELTA = WS_ENDX - WS_WIN;
constexpr size_t WS_END = WS_ENDX + (WS_HF - WS_WIN);

constexpr int CW_BAR = 4096;
constexpr int CW_Q5 = 32768;
constexpr int CW_LN1 = 163840;
constexpr int CW_CNT = 65536;

constexpr int RING_BYTES = 131072;
constexpr int MISC_OFF = RING_BYTES;
constexpr int MOE_TAB_OFF = RING_BYTES + 1024;
constexpr int ROWTAB_OFF = RING_BYTES + 4096;
constexpr int PTR_OFF = RING_BYTES + 2048;
constexpr int LDS_BYTES = 147456;

__device__ __forceinline__ float bf2f(bf16_t x) { return __uint_as_float(((unsigned)x) << 16); }
typedef __bf16 hwbf16x2 __attribute__((ext_vector_type(2)));
__device__ __forceinline__ unsigned pk2(float lo, float hi) { const f32x2 v = {lo, hi}; return __builtin_bit_cast(unsigned, __builtin_convertvector(v, hwbf16x2)); }
__device__ __forceinline__ unsigned f2bf(float f) { return pk2(f, 0.f) & 0xffffu; }
__device__ __forceinline__ float lo_bf(unsigned u) { return __uint_as_float(u << 16); }
__device__ __forceinline__ float hi_bf(unsigned u) { return __uint_as_float(u & 0xffff0000u); }
__device__ __forceinline__ float shx(float v, int o, int lane) { return __int_as_float(__builtin_amdgcn_ds_bpermute((lane ^ o) << 2, __float_as_int(v))); }
__device__ __forceinline__ float shi(float v, int src) { return __int_as_float(__builtin_amdgcn_ds_bpermute(src << 2, __float_as_int(v))); }
__device__ __forceinline__ float wave_sum(float v, int lane) {
#pragma unroll
    for (int o = 1; o < 64; o <<= 1) v += shx(v, o, lane);
    return v;
}
__device__ __forceinline__ float wave_max(float v, int lane) {
#pragma unroll
    for (int o = 1; o < 64; o <<= 1) v = fmaxf(v, shx(v, o, lane));
    return v;
}
__device__ __forceinline__ float sigmoidf_(float x) { return __builtin_amdgcn_rcpf(1.0f + __expf(-x)); }
__device__ __forceinline__ float siluf_(float x) { return x * __builtin_amdgcn_rcpf(1.0f + __expf(-x)); }
__device__ __forceinline__ float logsigmoidf_(float x) { return fminf(x, 0.f) - __logf(1.0f + __expf(-fabsf(x))); }
__device__ __forceinline__ float gelu_tanh(float x) { const float u = 1.5957691216057308f * (x + 0.044715f * x * x * x); return x * __builtin_amdgcn_rcpf(1.0f + __expf(-u)); }
__device__ __forceinline__ int lane_id() { int l; asm volatile("v_mbcnt_lo_u32_b32 %0, -1, 0\n\tv_mbcnt_hi_u32_b32 %0, -1, %0" : "=v"(l)); return l; }
__device__ __forceinline__ void ld8(const bf16_t* p, float* o) { const u32x4 w = *(const u32x4*)p; o[0] = lo_bf(w.x); o[1] = hi_bf(w.x); o[2] = lo_bf(w.y); o[3] = hi_bf(w.y); o[4] = lo_bf(w.z); o[5] = hi_bf(w.z); o[6] = lo_bf(w.w); o[7] = hi_bf(w.w); }
__device__ __forceinline__ void st8(bf16_t* p, const float* o) { u32x4 w; w.x = pk2(o[0], o[1]); w.y = pk2(o[2], o[3]); w.z = pk2(o[4], o[5]); w.w = pk2(o[6], o[7]); *(u32x4*)p = w; }
__device__ __forceinline__ void unpack8(u32x4 w, float* o) { o[0] = lo_bf(w.x); o[1] = hi_bf(w.x); o[2] = lo_bf(w.y); o[3] = hi_bf(w.y); o[4] = lo_bf(w.z); o[5] = hi_bf(w.z); o[6] = lo_bf(w.w); o[7] = hi_bf(w.w); }
__device__ __forceinline__ unsigned pk_fp8x4(float a, float b, float c, float d) { int p = __builtin_amdgcn_cvt_pk_fp8_f32(a, b, 0, false); p = __builtin_amdgcn_cvt_pk_fp8_f32(c, d, p, true); return (unsigned)p; }
__device__ __forceinline__ void st8_fp8(unsigned char* p, const float* o) { u32x2 w; w.x = pk_fp8x4(o[0], o[1], o[2], o[3]); w.y = pk_fp8x4(o[4], o[5], o[6], o[7]); *(u32x2*)p = w; }
__device__ __forceinline__ void unpack8_fp8(unsigned lo, unsigned hi, float* o) { const f32x2 a = __builtin_amdgcn_cvt_pk_f32_fp8((int)lo, false), b = __builtin_amdgcn_cvt_pk_f32_fp8((int)lo, true), c = __builtin_amdgcn_cvt_pk_f32_fp8((int)hi, false), d = __builtin_amdgcn_cvt_pk_f32_fp8((int)hi, true);
    o[0] = a[0]; o[1] = a[1]; o[2] = b[0]; o[3] = b[1]; o[4] = c[0]; o[5] = c[1]; o[6] = d[0]; o[7] = d[1]; }
#define LDS_WAIT() asm volatile("s_waitcnt lgkmcnt(0)" ::: "memory")
#define VM_WAIT() asm volatile("s_waitcnt vmcnt(0)" ::: "memory")

#define XB_TMO      128
#define XB_XCNT(j)  (256  + 64 * (j))
#define XB_XSUB(j)  (1280 + 64 * (j))
#define XB_XGEN(j)  (2304 + 64 * (j))
#define XB_TOP      3328
#define XB_TOPGEN   3392
#define XCD_BAR_WORDS 3456
#define XB_SPIN_CAP (1u << 18)
__device__ __forceinline__ unsigned xb_ld(unsigned* p)              { return __hip_atomic_load(p, __ATOMIC_RELAXED, __HIP_MEMORY_SCOPE_AGENT); }
__device__ __forceinline__ unsigned xb_add(unsigned* p, unsigned v) { return __hip_atomic_fetch_add(p, v, __ATOMIC_RELAXED, __HIP_MEMORY_SCOPE_AGENT); }
__device__ __forceinline__ unsigned xb_xcc_id() { return (unsigned)__builtin_amdgcn_s_getreg((3 << 11) | 20) & 0xFu; }
#define XB_SPIN(cond, bar) do { unsigned _sp = 0; while (cond) { __builtin_amdgcn_s_sleep(1); \
    if ((++_sp & 255u) == 0u) { if (xb_ld(&(bar)[XB_TMO])) break; if (_sp > XB_SPIN_CAP) { atomicAdd(&(bar)[XB_TMO], 1u); break; } } } } while (0)
struct XcdBarrier { unsigned* bar; unsigned x; volatile LAS unsigned* st; };
__device__ __forceinline__ XcdBarrier xcd_barrier_post(unsigned* bar, volatile LAS unsigned* st) {
    XcdBarrier b; b.bar = bar; b.x = (unsigned)__builtin_amdgcn_readfirstlane((int)xb_xcc_id()); b.st = st;
    if (threadIdx.x == 0) (void)xb_add(&bar[XB_XCNT(b.x)], 1u);
    return b;
}
__device__ __forceinline__ void xcd_barrier_complete(unsigned* bar, unsigned x, unsigned& nloc, unsigned& nx) {
    const unsigned G = gridDim.x * gridDim.y * gridDim.z;
    unsigned sum, cnt, mine, sp = 0u;
    for (;;) {
        sum = 0u; cnt = 0u; mine = 0u;
#pragma unroll
        for (unsigned j = 0; j < 16; ++j) { const unsigned c = xb_ld(&bar[XB_XCNT(j)]); sum += c; cnt += (c > 0u) ? 1u : 0u; mine = (j == x) ? c : mine; }
        if (sum == G) break;
        __builtin_amdgcn_s_sleep(1);
        if ((++sp & 255u) == 0u) { if (xb_ld(&bar[XB_TMO])) break; if (sp > XB_SPIN_CAP) { atomicAdd(&bar[XB_TMO], 1u); break; } }
    }
    nloc = mine > 0u ? mine : 1u; nx = cnt > 0u ? cnt : 1u;
}
__device__ __forceinline__ void xcd_barrier(const XcdBarrier& b, int tid) {
    asm volatile("s_waitcnt vmcnt(0)" ::: "memory");
    __syncthreads();
    if (tid == 0) {
        unsigned* bar = b.bar;
        __builtin_amdgcn_s_waitcnt(0);
        unsigned nloc = b.st[0], nx = b.st[1];
        if (nloc == 0u) { xcd_barrier_complete(bar, b.x, nloc, nx); b.st[0] = nloc; b.st[1] = nx; }
        const unsigned old = xb_add(&bar[XB_XSUB(b.x)], 1u);
        const unsigned gen = old / nloc;
        if (old + 1u == (gen + 1u) * nloc) {
            __builtin_amdgcn_fence(__ATOMIC_RELEASE, "agent");
            asm volatile("s_waitcnt vmcnt(0)" ::: "memory");
            const unsigned og = xb_add(&bar[XB_TOP], 1u);
            const unsigned tg = og / nx;
            if (og + 1u == (tg + 1u) * nx) xb_add(&bar[XB_TOPGEN], 1u);
            else XB_SPIN(xb_ld(&bar[XB_TOPGEN]) == tg, bar);
            __builtin_amdgcn_fence(__ATOMIC_ACQUIRE, "agent");
            xb_add(&bar[XB_XGEN(b.x)], 1u);
            asm volatile("s_waitcnt vmcnt(0)" ::: "memory");
        } else {
            XB_SPIN(xb_ld(&bar[XB_XGEN(b.x)]) == gen, bar);
            __builtin_amdgcn_fence(__ATOMIC_ACQUIRE, "agent");
            asm volatile("s_waitcnt vmcnt(0)" ::: "memory");
        }
    }
    __syncthreads();
}

namespace pg8 {
constexpr int BM = 256, BK = 64, HALF = 128, HTB = HALF * BK * 2, STAGE_BYTES = 8 * HTB, NXCD = 8, WGM = 8;
__host__ __device__ __forceinline__ int lds_byte(int r, int c) { const int st = (r >> 4) * 2 + (c >> 5), rr = r & 15, cc = c & 31, ob = rr * 64 + cc * 2; return st * 1024 + (ob ^ (((ob >> 9) & 1) << 5)); }
__host__ __device__ __forceinline__ void stage_rc(int b, int& R, int& C) { const int st = b / 1024, sb = b % 1024, swz = sb ^ (((sb >> 9) & 1) << 5); R = (st >> 1) * 16 + swz / 64; C = (st & 1) * 32 + (swz % 64) / 2; }
__host__ __device__ __forceinline__ int perm32(int rho) { const int n = rho >> 4, i = rho & 15; return 8 * (i >> 2) + 4 * n + (i & 3); }
struct Unit { int pm, pn; const char* A; const char* B; int aux; };

struct StaticOrder {
    static constexpr bool GATHER = false;
    int nM, nN, nwg, G, c; const char* A; const char* B; size_t tA, tB;
    int skip_from = 1 << 30, skip_by = 0;
    __device__ void init(const void* A_, int lda, const void* B_, int ldb, int M, int N, int G_, int c_) { nM = M / BM; nN = N / BM; nwg = nM * nN; G = G_; c = c_; A = (const char*)A_; B = (const char*)B_; tA = (size_t)BM * lda * 2; tB = (size_t)BM * ldb * 2; }
    __device__ bool next(int i, Unit& u) const {
        const long L = (long)i * G + c; if (L >= nwg) return false;
        int wgid = (int)L; { const int q = nwg / NXCD, r = nwg % NXCD, xcd = wgid % NXCD, off = wgid / NXCD; wgid = (xcd < r ? xcd * (q + 1) : r * (q + 1) + (xcd - r) * q) + off; }
        const int nig = WGM * nN, gid = wgid / nig, fm = gid * WGM, gsz = (nM - fm) < WGM ? (nM - fm) : WGM;
        u.pm = fm + ((wgid % nig) % gsz); u.pn = (wgid % nig) / gsz; if (u.pn >= skip_from) u.pn += skip_by; u.A = A + (size_t)u.pm * tA; u.B = B + (size_t)u.pn * tB; return true;
    }
};

struct SplitKOrder {
    static constexpr bool GATHER = false;
    int nN, nwg, G, c, KSPL; const char* A; const char* B; size_t tA, tB, kb;
    __device__ void init(const void* A_, int lda, const void* B_, int ldb, int M, int N, int Kc, int KSPL_, int G_, int c_) { nN = N / BM; KSPL = KSPL_; nwg = (M / BM) * nN * KSPL; G = G_; c = c_; A = (const char*)A_; B = (const char*)B_; tA = (size_t)BM * lda * 2; tB = (size_t)BM * ldb * 2; kb = (size_t)Kc * 2; }
    __device__ bool next(int i, Unit& u) const {
        const long L = (long)i * G + c; if (L >= nwg) return false;
        const int tile = (int)(L / KSPL), ks = (int)(L % KSPL); u.pm = tile / nN; u.pn = tile % nN; u.aux = ks; u.A = A + (size_t)u.pm * tA + ks * kb; u.B = B + (size_t)u.pn * tB + ks * kb; return true;
    }
};

struct BranchOrder {
    static constexpr bool GATHER = false;
    StaticOrder S0; const char* A; const char* B; size_t ks;
    __device__ bool next(int i, Unit& u) const { if (!S0.next(i >> 2, u)) return false; const int nb = i & 3; u.aux = nb; u.A += (size_t)nb * ks; u.B += (size_t)nb * ks; return true; }
};
template <class E, class = void> struct EpiAccum { static constexpr bool v = false; };
template <class E> struct EpiAccum<E, decltype((void)E::ACCUM)> { static constexpr bool v = E::ACCUM; };

template <class Epi, class Sched>
__device__ __forceinline__ void gemm_phase(LAS unsigned char* lds, int tid, int lda, int ldb, int K, const Sched& S, const Epi& E) {
    const int wid = __builtin_amdgcn_readfirstlane(tid >> 6), lane = tid & 63, wr = wid >> 2, wc = wid & 3, fr = lane & 15, fq = lane >> 4;
    const int nt = K / BK;
    unsigned voffB[2]; int RA[2], CA[2];
#pragma unroll
    for (int i = 0; i < 2; ++i) { int R, C; stage_rc(tid * 16 + i * 8192, R, C); RA[i] = R; CA[i] = C; const int Rb = Epi::PERM ? ((R & ~31) + perm32(R & 31)) : R; voffB[i] = (unsigned)(Rb * ldb + C) * 2u; }
    const size_t kstep = (size_t)(BK * 2);
    const size_t hstepA = (size_t)HALF * lda * 2, hstepB = (size_t)HALF * ldb * 2;
    const unsigned ldsw = (unsigned)wid * 1024u;
    const int aoff = lds_byte(wr * 64 + fr, fq * 8), boff = lds_byte(wc * 32 + fr, fq * 8);
#define PG8_SA(b, h) (((b) * 2 + (h)) * HTB)
#define PG8_SB(b, h) ((4 + (b) * 2 + (h)) * HTB)
#define PG8_STAGE_G(bufoff, gbase, voff, isB) do { _Pragma("unroll") for (int _i = 0; _i < 2; ++_i) \
        __builtin_amdgcn_raw_ptr_buffer_load_lds((isB) ? rsB : rsA, (LAS void*)(lds + (bufoff) + ldsw + _i * 8192), 16, (int)(voff)[_i], (int)(unsigned)((const char*)(gbase) - ((isB) ? S.B : S.A)), 0, 0); } while (0)
#define PG8_STAGE(bufoff, gbase, voff) PG8_STAGE_G(bufoff, gbase, voff, 1)
#define PG8_STAGE_A(bufoff, gbase, h, o0, o1) do { if constexpr (Sched::GATHER) { if (h) PG8_STAGE_G(bufoff, gbase, o1, 0); else PG8_STAGE_G(bufoff, gbase, o0, 0); } else PG8_STAGE_G(bufoff, (gbase) + (h) * hstepA, o0, 0); } while (0)
#define PG8_LD8(dst, p0, p1) do { (dst).lo = *(const LAS v4i_t*)(p0); (dst).hi = *(const LAS v4i_t*)(p1); } while (0)
#define PG8_LDA(dst, b, h) do { if constexpr (Epi::FP8) { _Pragma("unroll") for (int m = 0; m < 4; ++m) PG8_LD8(dst##8[m], lds + PG8_SA(b, h) + aoff + m * 2048, lds + PG8_SA(b, h) + aoff + m * 2048 + 1024); } \
    else { _Pragma("unroll") for (int m = 0; m < 4; ++m) _Pragma("unroll") for (int k = 0; k < 2; ++k) dst[m][k] = *(const LAS bf16x8*)(lds + PG8_SA(b, h) + aoff + m * 2048 + k * 1024); } } while (0)
#define PG8_LDB(dst, b, h) do { if constexpr (Epi::FP8) { _Pragma("unroll") for (int n = 0; n < 2; ++n) PG8_LD8(dst##8[n], lds + PG8_SB(b, h) + boff + n * 2048, lds + PG8_SB(b, h) + boff + n * 2048 + 1024); } \
    else { _Pragma("unroll") for (int n = 0; n < 2; ++n) _Pragma("unroll") for (int k = 0; k < 2; ++k) dst[n][k] = *(const LAS bf16x8*)(lds + PG8_SB(b, h) + boff + n * 2048 + k * 1024); } } while (0)
#define PG8_MMA(ai, bj, At, Bt) do { if constexpr (Epi::FP8) { PG8_MMA8(ai, bj, At, Bt); } else { __builtin_amdgcn_s_setprio(1); _Pragma("unroll") for (int m = 0; m < 4; ++m) _Pragma("unroll") for (int n = 0; n < 2; ++n) _Pragma("unroll") for (int k = 0; k < 2; ++k) \
        acc[ai][bj][m][n] = __builtin_amdgcn_mfma_f32_16x16x32_bf16(Bt[n][k], At[m][k], acc[ai][bj][m][n], 0, 0, 0); __builtin_amdgcn_s_setprio(0); } } while (0)
#define PG8_MMA8(ai, bj, At, Bt) do { __builtin_amdgcn_s_setprio(1); _Pragma("unroll") for (int m = 0; m < 4; ++m) _Pragma("unroll") for (int n = 0; n < 2; ++n) \
        acc[ai][bj][m][n] = __builtin_amdgcn_mfma_scale_f32_16x16x128_f8f6f4(Bt##8[n], At##8[m], acc[ai][bj][m][n], 0, 0, 0, 0x7F7F7F7F, 0, 0x7F7F7F7F); __builtin_amdgcn_s_setprio(0); } while (0)
#define PG8_WAIT_V(n) asm volatile("s_waitcnt vmcnt(" #n ")" ::: "memory")
#define PG8_WAIT_L(n) asm volatile("s_waitcnt lgkmcnt(" #n ")" ::: "memory")
#define PG8_BAR __builtin_amdgcn_s_barrier()
#define PG8_SCHED __builtin_amdgcn_sched_barrier(0)
    Unit cur, nxt; int ui = 0;
    if (!S.next(0, cur)) return;
    const __amdgpu_buffer_rsrc_t rsA = __builtin_amdgcn_make_buffer_rsrc((void*)S.A, 0, 0x7fffffff, 0x00020000), rsB = __builtin_amdgcn_make_buffer_rsrc((void*)S.B, 0, 0x7fffffff, 0x00020000);
    f32x4 acc[2][2][4][2];
    { float zz; asm volatile("v_mov_b32 %0, 0" : "=v"(zz));
#pragma unroll
    for (int a = 0; a < 2; ++a)
#pragma unroll
        for (int b = 0; b < 2; ++b)
#pragma unroll
            for (int m = 0; m < 4; ++m)
#pragma unroll
                for (int n = 0; n < 2; ++n) acc[a][b][m][n] = (f32x4){zz, zz, zz, zz}; }
    bf16x8 At[4][2], B0[2][2], B1[2][2]; v8i_t At8[4], B08[2], B18[2];
    const char* cA = cur.A; const char* cB = cur.B;
    unsigned vA0[2], vA1[2];
#define PG8_AOFFS(d0, d1, un) do { _Pragma("unroll") for (int _i = 0; _i < 2; ++_i) { if constexpr (Sched::GATHER) { d0[_i] = S.row_off(un, RA[_i]) + (unsigned)CA[_i] * 2u; d1[_i] = S.row_off(un, HALF + RA[_i]) + (unsigned)CA[_i] * 2u; } \
        else { d0[_i] = (unsigned)(RA[_i] * lda + CA[_i]) * 2u; d1[_i] = 0u; } } } while (0)
    PG8_AOFFS(vA0, vA1, cur);
    PG8_STAGE(PG8_SB(0, 0), cB, voffB); PG8_STAGE(PG8_SB(0, 1), cB + hstepB, voffB); PG8_STAGE_A(PG8_SA(0, 0), cA, 0, vA0, vA1); PG8_STAGE_A(PG8_SA(0, 1), cA, 1, vA0, vA1);
    if (wr == 1) PG8_BAR;
    PG8_WAIT_V(2); PG8_BAR;
    PG8_STAGE(PG8_SB(1, 0), cB + kstep, voffB); PG8_STAGE_A(PG8_SA(1, 0), cA + kstep, 0, vA0, vA1); PG8_STAGE(PG8_SB(1, 1), cB + hstepB + kstep, voffB);
    PG8_WAIT_V(6); PG8_BAR;
    for (;;) {
        const bool has_next = S.next(ui + 1, nxt);
        const char* nA = has_next ? nxt.A : cA; const char* nB = has_next ? nxt.B : cB;
#pragma unroll 1
        for (int t = 0; t < nt; t += 2) {
            const bool last = (t == nt - 2);
            const char* a1 = cA + (size_t)(t + 1) * kstep;
            const char* a2 = last ? nA : cA + (size_t)(t + 2) * kstep; const char* b2 = last ? nB : cB + (size_t)(t + 2) * kstep;
            const char* a3 = a2 + kstep; const char* b3 = b2 + kstep;
            PG8_LDB(B0, 0, 0); PG8_LDB(B1, 0, 1); PG8_SCHED; PG8_LDA(At, 0, 0); PG8_STAGE_A(PG8_SA(1, 1), a1, 1, vA0, vA1);
            PG8_WAIT_V(8); PG8_WAIT_L(0); PG8_BAR; PG8_MMA(0, 0, At, B0); PG8_MMA(0, 1, At, B1); PG8_BAR; PG8_SCHED;
            if constexpr (Sched::GATHER) { if (last && has_next) PG8_AOFFS(vA0, vA1, nxt); }
            PG8_LDA(At, 0, 1); PG8_STAGE(PG8_SB(0, 0), b2, voffB); PG8_STAGE(PG8_SB(0, 1), b2 + hstepB, voffB); PG8_STAGE_A(PG8_SA(0, 0), a2, 0, vA0, vA1);
            PG8_WAIT_V(8); PG8_WAIT_L(0); PG8_BAR; PG8_MMA(1, 0, At, B0); PG8_MMA(1, 1, At, B1); PG8_BAR; PG8_SCHED;
            PG8_LDB(B0, 1, 0); PG8_LDB(B1, 1, 1); PG8_SCHED; PG8_LDA(At, 1, 0); PG8_STAGE_A(PG8_SA(0, 1), a2, 1, vA0, vA1);
            PG8_WAIT_V(8); PG8_WAIT_L(0); PG8_BAR; PG8_MMA(0, 0, At, B0); PG8_MMA(0, 1, At, B1); PG8_BAR; PG8_SCHED;
            PG8_LDA(At, 1, 1); PG8_STAGE(PG8_SB(1, 0), b3, voffB); PG8_STAGE(PG8_SB(1, 1), b3 + hstepB, voffB); PG8_STAGE_A(PG8_SA(1, 0), a3, 0, vA0, vA1);
            PG8_WAIT_V(8); PG8_WAIT_L(0); PG8_BAR; PG8_MMA(1, 0, At, B0); PG8_MMA(1, 1, At, B1); PG8_BAR; PG8_SCHED;
            if constexpr (Epi::KHOOK) { constexpr int HP = Epi::FP8 ? 4 : 8; if (!last && ((t + 2) & (HP - 1)) == 0) { const int tz = lane_id(); E.khook(acc, cur, (t + 2) / HP, wr, wc, tz & 15, tz >> 4); } }
        }
        if (wr == 0) PG8_BAR;
        { const int tz = lane_id(); if constexpr (Epi::MUT) E.fused(acc, cur, wr, wc, tz & 15, tz >> 4); else E(acc, cur, wr, wc, tz & 15, tz >> 4); }
        if (!has_next) break;
        bool keep = false; if constexpr (EpiAccum<Epi>::v) keep = cur.aux < 3;
        if (!keep) { float zz; asm volatile("v_mov_b32 %0, 0" : "=v"(zz));
#pragma unroll
        for (int a = 0; a < 2; ++a)
#pragma unroll
            for (int b = 0; b < 2; ++b)
#pragma unroll
                for (int m = 0; m < 4; ++m)
#pragma unroll
                    for (int n = 0; n < 2; ++n) acc[a][b][m][n] = (f32x4){zz, zz, zz, zz}; }
        cur = nxt; cA = nA; cB = nB; ++ui;
        if (wr == 1) PG8_BAR;
    }
    PG8_WAIT_V(0);
    PG8_BAR;
#undef PG8_AOFFS
#undef PG8_LD8
#undef PG8_MMA8
#undef PG8_STAGE_A
#undef PG8_STAGE_G
#undef PG8_SA
#undef PG8_SB
#undef PG8_STAGE
#undef PG8_LDA
#undef PG8_LDB
#undef PG8_MMA
#undef PG8_WAIT_V
#undef PG8_WAIT_L
#undef PG8_BAR
#undef PG8_SCHED
}
}

#define EPI_LOOP_BEGIN _Pragma("unroll") for (int ai = 0; ai < 2; ++ai) _Pragma("unroll") for (int m = 0; m < 4; ++m) { const int row = u.pm * 256 + ai * 128 + wr * 64 + m * 16 + fr; \
    _Pragma("unroll") for (int bj = 0; bj < 2; ++bj) _Pragma("unroll") for (int n = 0; n < 2; ++n) { const int col = u.pn * 256 + bj * 128 + wc * 32 + n * 16 + 4 * fq; f32x4 v = acc[ai][bj][m][n];
#define EPI_LOOP_END } }
#define EPI8_LOOP_BEGIN _Pragma("unroll") for (int ai = 0; ai < 2; ++ai) _Pragma("unroll") for (int m = 0; m < 4; ++m) { const int row = u.pm * 256 + ai * 128 + wr * 64 + m * 16 + fr; \
    _Pragma("unroll") for (int bj = 0; bj < 2; ++bj) { const int col = u.pn * 256 + bj * 128 + wc * 32 + 8 * fq; f32x4 v0 = acc[ai][bj][m][0], v1 = acc[ai][bj][m][1];
#define EPI8_LOOP_END } }
typedef f32x4 AccT[2][2][4][2];

__device__ __forceinline__ void st_bf16x8(bf16_t* p, f32x4 a, f32x4 b) { u32x4 w; w.x = pk2(a[0], a[1]); w.y = pk2(a[2], a[3]); w.z = pk2(b[0], b[1]); w.w = pk2(b[2], b[3]); *(u32x4*)p = w; }
__device__ __forceinline__ void st_bf16x4(bf16_t* p, f32x4 v) { u32x2 w; w.x = pk2(v[0], v[1]); w.y = pk2(v[2], v[3]); *(u32x2*)p = w; }

struct EpiGate { static constexpr bool KHOOK = false, PERM = true, MUT = false, FP8 = true; unsigned char* GQ;
    __device__ __forceinline__ void operator()(const AccT& acc, const pg8::Unit& u, int wr, int wc, int fr, int fq) const {
        const int tid = (wr * 4 + wc) * 64 + fq * 16 + fr; u32x4* gp = (u32x4*)GQ + ((size_t)(u.pm * 32 + u.pn) * 8) * 512 + tid;
#pragma unroll
        for (int ai = 0; ai < 2; ++ai)
#pragma unroll
            for (int m = 0; m < 4; ++m) { u32x4 o = (u32x4){0u, 0u, 0u, 0u};
#pragma unroll
                for (int bj = 0; bj < 2; ++bj)
#pragma unroll
                    for (int n = 0; n < 2; ++n) { const f32x4 t = acc[ai][bj][m][n] * (-LOG2E / 64.0f); f32x4 e; unsigned wv = 0;
#pragma unroll
                        for (int j = 0; j < 4; ++j) e[j] = __builtin_amdgcn_exp2f(t[j]);
                        const f32x4 d = e * (1.0f / 256.0f) + (1.0f / 256.0f); f32x4 r;
#pragma unroll
                        for (int j = 0; j < 4; ++j) r[j] = __builtin_amdgcn_rcpf(d[j]);
                        const f32x4 q = r - 0.5f;
#pragma unroll
                        for (int j = 0; j < 4; ++j) wv = __builtin_amdgcn_cvt_pk_u8_f32(q[j], (unsigned)j, wv);
                        o[bj * 2 + n] = wv; }
                __builtin_nontemporal_store(o, gp + (size_t)(ai * 4 + m) * 512); }
    }
};
template <bool F8> struct EpiInProjT { static constexpr bool KHOOK = false, PERM = true, MUT = false, FP8 = F8; bf16_t* Z;
    __device__ __forceinline__ void operator()(const AccT& acc, const pg8::Unit& u, int wr, int wc, int fr, int fq) const {
        const int mode = (u.pn < 4) ? 1 : 0; const float sc = F8 ? (1.0f / 64.0f) : 1.0f;
        EPI8_LOOP_BEGIN
            v0 *= sc; v1 *= sc;
            if (mode == 1) {
#pragma unroll
                for (int j = 0; j < 4; ++j) { v0[j] = gelu_tanh(v0[j]); v1[j] = gelu_tanh(v1[j]); } }
            st_bf16x8(Z + (size_t)row * ZLD + col, v0, v1);
        EPI8_LOOP_END
    }
};
template <bool F8> struct EpiBf16T { static constexpr bool KHOOK = false, PERM = true, MUT = false, FP8 = F8; bf16_t* O; int ldo; float scale;
    __device__ __forceinline__ void operator()(const AccT& acc, const pg8::Unit& u, int wr, int wc, int fr, int fq) const {
        EPI8_LOOP_BEGIN
            st_bf16x8(O + (size_t)row * ldo + col, v0 * scale, v1 * scale);
        EPI8_LOOP_END
    }
};
struct EpiFp8T { static constexpr bool KHOOK = false, PERM = true, MUT = false, FP8 = true; unsigned char* O; int ldo; float scale;
    __device__ __forceinline__ void operator()(const AccT& acc, const pg8::Unit& u, int wr, int wc, int fr, int fq) const {
        EPI8_LOOP_BEGIN
            { u32x2 w_; w_.x = pk_fp8x4(v0[0] * scale, v0[1] * scale, v0[2] * scale, v0[3] * scale); w_.y = pk_fp8x4(v1[0] * scale, v1[1] * scale, v1[2] * scale, v1[3] * scale); *(u32x2*)(O + (size_t)row * ldo + col) = w_; }
        EPI8_LOOP_END
    }
};
struct EpiBf16P { static constexpr bool KHOOK = false, PERM = true, MUT = false, FP8 = true; bf16_t* P; int ldo; size_t slab;
    __device__ __forceinline__ void operator()(const AccT& acc, const pg8::Unit& u, int wr, int wc, int fr, int fq) const {
        EPI8_LOOP_BEGIN
            st_bf16x8(P + (size_t)u.aux * slab + (size_t)row * ldo + col, v0 * (1.0f / 64.0f), v1 * (1.0f / 64.0f));
        EPI8_LOOP_END
    }
};
struct EpiQ { static constexpr bool KHOOK = false, PERM = true, MUT = false, FP8 = false; bf16_t* Q; const f32x2* cs; float scale;
    __device__ __forceinline__ void operator()(const AccT& acc, const pg8::Unit& u, int wr, int wc, int fr, int fq) const {
        EPI8_LOOP_BEGIN
            const int j = col % 192;
            if (j >= 128) { const int i0 = (j - 128) >> 1; const f32x2 c0 = cs[(size_t)row * 32 + i0], c1 = cs[(size_t)row * 32 + i0 + 1], c2 = cs[(size_t)row * 32 + i0 + 2], c3 = cs[(size_t)row * 32 + i0 + 3];
                v0 = (f32x4){v0[0] * c0.x - v0[1] * c0.y, v0[0] * c0.y + v0[1] * c0.x, v0[2] * c1.x - v0[3] * c1.y, v0[2] * c1.y + v0[3] * c1.x};
                v1 = (f32x4){v1[0] * c2.x - v1[1] * c2.y, v1[0] * c2.y + v1[1] * c2.x, v1[2] * c3.x - v1[3] * c3.y, v1[2] * c3.y + v1[3] * c3.x}; }
            st_bf16x8(Q + (size_t)row * 768 + col, v0 * scale, v1 * scale);
        EPI8_LOOP_END
    }
};
struct EpiKV { static constexpr bool KHOOK = false, PERM = true, MUT = false, FP8 = false; bf16_t* KN; bf16_t* V;
    __device__ __forceinline__ void operator()(const AccT& acc, const pg8::Unit& u, int wr, int wc, int fr, int fq) const {
        EPI8_LOOP_BEGIN
            const int h = col >> 8, j = col & 255;
            bf16_t* dst = (j < 128) ? (KN + (size_t)row * 512 + h * 128 + j) : (V + (size_t)row * 512 + h * 128 + (j - 128));
            st_bf16x8(dst, v0, v1);
        EPI8_LOOP_END
    }
};
struct EpiBranch { static constexpr bool KHOOK = true, PERM = true, MUT = false, FP8 = false; unsigned char* O; const unsigned char* GQ;
    __device__ __forceinline__ const u32x4* gptr(const pg8::Unit& u, int nb, int wr, int wc, int fr, int fq) const { const int tid = (wr * 4 + wc) * 64 + fq * 16 + fr; return (const u32x4*)GQ + ((size_t)(u.pm * 32 + nb * 8 + u.pn) * 8) * 512 + tid; }
    __device__ __forceinline__ void khook(AccT& acc, const pg8::Unit& u, int nb, int wr, int wc, int fr, int fq) const {
        const u32x4* g0 = gptr(u, nb - 1, wr, wc, fr, fq); const u32x4* g1 = gptr(u, nb, wr, wc, fr, fq);
        u32x4 a[8], b[8];
#pragma unroll
        for (int c = 0; c < 8; ++c) { a[c] = g0[(size_t)c * 512]; b[c] = g1[(size_t)c * 512]; }
#pragma unroll
        for (int ai = 0; ai < 2; ++ai)
#pragma unroll
            for (int m = 0; m < 4; ++m)
#pragma unroll
                for (int bj = 0; bj < 2; ++bj)
#pragma unroll
                    for (int n = 0; n < 2; ++n) { const unsigned wa = a[ai * 4 + m][bj * 2 + n], wb = b[ai * 4 + m][bj * 2 + n];
#pragma unroll
                        for (int j = 0; j < 4; ++j) { const float ga = (float)((wa >> (8 * j)) & 255u) + 0.5f, gb = (float)((wb >> (8 * j)) & 255u) + 0.5f;
                            acc[ai][bj][m][n][j] *= ga * __builtin_amdgcn_rcpf(gb); } }
    }
    __device__ __forceinline__ void operator()(const AccT& acc, const pg8::Unit& u, int wr, int wc, int fr, int fq) const {
        const u32x4* g3 = gptr(u, 3, wr, wc, fr, fq);
        u32x4 a[8];
#pragma unroll
        for (int c = 0; c < 8; ++c) a[c] = g3[(size_t)c * 512];
        EPI8_LOOP_BEGIN
            const unsigned wa0 = a[ai * 4 + m][bj * 2 + 0], wa1 = a[ai * 4 + m][bj * 2 + 1];
#pragma unroll
            for (int j = 0; j < 4; ++j) { v0[j] *= ((float)((wa0 >> (8 * j)) & 255u) + 0.5f) * (1.0f / 256.0f); v1[j] *= ((float)((wa1 >> (8 * j)) & 255u) + 0.5f) * (1.0f / 256.0f); }
            { u32x2 w_; w_.x = pk_fp8x4(v0[0], v0[1], v0[2], v0[3]); w_.y = pk_fp8x4(v1[0], v1[1], v1[2], v1[3]); *(u32x2*)(O + (size_t)row * DM + col) = w_; }
        EPI8_LOOP_END
    }
};
struct EpiBranch8 { static constexpr bool KHOOK = false, PERM = true, MUT = true, FP8 = true, ACCUM = true; unsigned char* O; const unsigned char* GQ;
    __device__ __forceinline__ const u32x4* gptr(const pg8::Unit& u, int nb, int wr, int wc, int fr, int fq) const { const int tid = (wr * 4 + wc) * 64 + fq * 16 + fr; return (const u32x4*)GQ + ((size_t)(u.pm * 32 + nb * 8 + u.pn) * 8) * 512 + tid; }
    __device__ __forceinline__ void fused(AccT& acc, const pg8::Unit& u, int wr, int wc, int fr, int fq) const {
        if (u.aux < 3) {
            const u32x4* g0 = gptr(u, u.aux, wr, wc, fr, fq); const u32x4* g1 = gptr(u, u.aux + 1, wr, wc, fr, fq);
            u32x4 a[8], b[8];
#pragma unroll
            for (int c = 0; c < 8; ++c) { a[c] = __builtin_nontemporal_load(g0 + (size_t)c * 512); b[c] = g1[(size_t)c * 512]; }
#pragma unroll
            for (int ai = 0; ai < 2; ++ai)
#pragma unroll
                for (int m = 0; m < 4; ++m)
#pragma unroll
                    for (int bj = 0; bj < 2; ++bj)
#pragma unroll
                        for (int n = 0; n < 2; ++n) { const unsigned wa = a[ai * 4 + m][bj * 2 + n], wb = b[ai * 4 + m][bj * 2 + n];
                            f32x4 fa = (f32x4){(float)(wa & 255u), (float)((wa >> 8) & 255u), (float)((wa >> 16) & 255u), (float)(wa >> 24)}, fb = (f32x4){(float)(wb & 255u), (float)((wb >> 8) & 255u), (float)((wb >> 16) & 255u), (float)(wb >> 24)}, r;
                            fa += 0.5f; fb += 0.5f;
#pragma unroll
                            for (int j = 0; j < 4; ++j) r[j] = __builtin_amdgcn_rcpf(fb[j]);
                            acc[ai][bj][m][n] *= fa * r; }
        } else {
            const u32x4* g3 = gptr(u, 3, wr, wc, fr, fq);
            u32x4 a[8];
#pragma unroll
            for (int c = 0; c < 8; ++c) a[c] = __builtin_nontemporal_load(g3 + (size_t)c * 512);
            EPI8_LOOP_BEGIN
                const unsigned wa0 = a[ai * 4 + m][bj * 2 + 0], wa1 = a[ai * 4 + m][bj * 2 + 1];
#pragma unroll
                for (int j = 0; j < 4; ++j) { v0[j] *= ((float)((wa0 >> (8 * j)) & 255u) + 0.5f) * (1.0f / (256.0f * 64.0f)); v1[j] *= ((float)((wa1 >> (8 * j)) & 255u) + 0.5f) * (1.0f / (256.0f * 64.0f)); }
                { u32x2 w_; w_.x = pk_fp8x4(v0[0], v0[1], v0[2], v0[3]); w_.y = pk_fp8x4(v1[0], v1[1], v1[2], v1[3]); *(u32x2*)(O + (size_t)row * DM + col) = w_; }
            EPI8_LOOP_END
        }
    }
};
struct EpiResid { static constexpr bool KHOOK = false, PERM = true, MUT = false, FP8 = false; const bf16_t* H; bf16_t* T;
    __device__ __forceinline__ void operator()(const AccT& acc, const pg8::Unit& u, int wr, int wc, int fr, int fq) const {
        EPI8_LOOP_BEGIN
            float h[8]; ld8(H + (size_t)row * DM + col, h);
#pragma unroll
            for (int j = 0; j < 4; ++j) { v0[j] += ALPHA * h[j]; v1[j] += ALPHA * h[4 + j]; }
            st_bf16x8(T + (size_t)row * DM + col, v0, v1);
        EPI8_LOOP_END
    }
};
template <bool F8> struct EpiResidLNT { static constexpr bool KHOOK = false, PERM = true, MUT = true, FP8 = F8;
    bf16_t* H; const float* g; const float* b; unsigned long long* xs; unsigned* cnt; LAS unsigned char* lds; unsigned char* H8;
    __device__ __forceinline__ void fused(AccT& acc, const pg8::Unit& u, int wr, int wc, int fr, int fq) const {
        LAS f32x2* P = (LAS f32x2*)(lds + ROWTAB_OFF); LAS f32x2* S = (LAS f32x2*)(lds + ROWTAB_OFF + 8192);
        const int lane = fq * 16 + fr, tid = (wr * 4 + wc) * 64 + lane;
#pragma unroll
        for (int ai = 0; ai < 2; ++ai)
#pragma unroll
            for (int m = 0; m < 4; ++m) { const int rl = ai * 128 + wr * 64 + m * 16 + fr; const size_t row = (size_t)u.pm * 256 + rl; float s1 = 0.f, s2 = 0.f;
#pragma unroll
                for (int bj = 0; bj < 2; ++bj) { const int col = u.pn * 256 + bj * 128 + wc * 32 + 8 * fq; float h[8]; unpack8(__builtin_nontemporal_load((const u32x4*)(H + row * DM + col)), h);
#pragma unroll
                    for (int j = 0; j < 4; ++j) { const float asc = F8 ? (1.0f / 64.0f) : 1.0f; const float x0 = acc[ai][bj][m][0][j] * asc + ALPHA * h[j], x1 = acc[ai][bj][m][1][j] * asc + ALPHA * h[4 + j];
                        acc[ai][bj][m][0][j] = x0; acc[ai][bj][m][1][j] = x1; s1 += x0 + x1; s2 += x0 * x0 + x1 * x1; } }
                s1 += shx(s1, 16, lane); s1 += shx(s1, 32, lane); s2 += shx(s2, 16, lane); s2 += shx(s2, 32, lane);
                if (fq == 0) P[rl * 4 + wc] = (f32x2){s1, s2}; }
        asm volatile("s_waitcnt lgkmcnt(0)" ::: "memory"); __builtin_amdgcn_s_barrier(); asm volatile("" ::: "memory");
        unsigned long long* slot = xs + ((size_t)u.pm * 256) * 8;
        if (tid < 256) { const f32x2 a0 = P[tid * 4 + 0], a1 = P[tid * 4 + 1], a2 = P[tid * 4 + 2], a3 = P[tid * 4 + 3]; const float t1 = (a0.x + a1.x) + (a2.x + a3.x), t2 = (a0.y + a1.y) + (a2.y + a3.y);
            __hip_atomic_store(slot + (size_t)tid * 8 + u.pn, ((unsigned long long)__float_as_uint(t2) << 32) | __float_as_uint(t1), __ATOMIC_RELAXED, __HIP_MEMORY_SCOPE_AGENT); }
        asm volatile("s_waitcnt vmcnt(0)" ::: "memory"); __builtin_amdgcn_s_barrier(); asm volatile("" ::: "memory");
        if (tid == 0) { unsigned* c = cnt + 64 * u.pm; __hip_atomic_fetch_add(c, 1u, __ATOMIC_RELAXED, __HIP_MEMORY_SCOPE_AGENT); unsigned sp = 0;
            while (__hip_atomic_load(c, __ATOMIC_RELAXED, __HIP_MEMORY_SCOPE_AGENT) < 8u && ++sp < (1u << 21)) __builtin_amdgcn_s_sleep(1); }
        asm volatile("" ::: "memory"); __builtin_amdgcn_s_barrier(); asm volatile("" ::: "memory");
        if (tid < 256) { float t1 = 0.f, t2 = 0.f;
#pragma unroll
            for (int t = 0; t < 8; ++t) { const unsigned long long v = __hip_atomic_load(slot + (size_t)tid * 8 + t, __ATOMIC_RELAXED, __HIP_MEMORY_SCOPE_AGENT); t1 += __uint_as_float((unsigned)v); t2 += __uint_as_float((unsigned)(v >> 32)); }
            const float mean = t1 * (1.f / DM), var = fmaxf(t2 * (1.f / DM) - mean * mean, 0.f); S[tid] = (f32x2){mean, __builtin_amdgcn_rsqf(var + LN_EPS)}; }
        asm volatile("s_waitcnt lgkmcnt(0)" ::: "memory"); __builtin_amdgcn_s_barrier(); asm volatile("" ::: "memory");
        f32x4 gq[2][2], bq[2][2];
#pragma unroll
        for (int bj = 0; bj < 2; ++bj) { const int col = u.pn * 256 + bj * 128 + wc * 32 + 8 * fq; gq[bj][0] = *(const f32x4*)(g + col); gq[bj][1] = *(const f32x4*)(g + col + 4); bq[bj][0] = *(const f32x4*)(b + col); bq[bj][1] = *(const f32x4*)(b + col + 4); }
#pragma unroll
        for (int ai = 0; ai < 2; ++ai)
#pragma unroll
            for (int m = 0; m < 4; ++m) { const int rl = ai * 128 + wr * 64 + m * 16 + fr; const size_t row = (size_t)u.pm * 256 + rl; const f32x2 ms = S[rl];
#pragma unroll
                for (int bj = 0; bj < 2; ++bj) { const int col = u.pn * 256 + bj * 128 + wc * 32 + 8 * fq;
                    const f32x4 g0 = gq[bj][0], g1 = gq[bj][1], b0 = bq[bj][0], b1 = bq[bj][1]; f32x4 y0, y1;
#pragma unroll
                    for (int j = 0; j < 4; ++j) { y0[j] = (acc[ai][bj][m][0][j] - ms.x) * ms.y * g0[j] + b0[j]; y1[j] = (acc[ai][bj][m][1][j] - ms.x) * ms.y * g1[j] + b1[j]; }
                    st_bf16x8(H + row * DM + col, y0, y1);
                    if (H8 != nullptr) { u32x2 w8; w8.x = pk_fp8x4(y0[0], y0[1], y0[2], y0[3]); w8.y = pk_fp8x4(y1[0], y1[1], y1[2], y1[3]); *(u32x2*)(H8 + row * DM + col) = w8; } } }
    }
};
struct EpiGU { static constexpr bool KHOOK = false, PERM = true, MUT = false, FP8 = true; unsigned char* HID;
    const LAS float* roww;
    __device__ __forceinline__ void operator()(const AccT& acc, const pg8::Unit& u, int wr, int wc, int fr, int fq) const {
#pragma unroll
        for (int ai = 0; ai < 2; ++ai)
#pragma unroll
            for (int m = 0; m < 4; ++m) { const int lrow = ai * 128 + wr * 64 + m * 16 + fr, row = u.pm * 256 + lrow; const float w = roww[u.aux * 256 + lrow] * (1.0f / 64.0f);
#pragma unroll
                for (int bj = 0; bj < 2; ++bj) { const int f = u.pn * 128 + bj * 64 + wc * 16 + 4 * fq; const f32x4 g = acc[ai][bj][m][0], up = acc[ai][bj][m][1]; f32x4 e, r;
                    const f32x4 t = g * (-LOG2E / 64.0f);
#pragma unroll
                    for (int j = 0; j < 4; ++j) e[j] = __builtin_amdgcn_exp2f(t[j]);
                    const f32x4 d = e + 1.0f;
#pragma unroll
                    for (int j = 0; j < 4; ++j) r[j] = __builtin_amdgcn_rcpf(d[j]);
                    const f32x4 o = (g * up) * (r * (w * (1.0f / 64.0f)));
                    *(unsigned*)(HID + (size_t)row * 512 + f) = pk_fp8x4(o[0], o[1], o[2], o[3]); } }
    }
};

struct MoeOrder {
    static constexpr bool GATHER = false;
    int G, c, NC, nrt; const char* A; const char* B; size_t tA, tB, eB; const LAS int* rt2e;
    __device__ bool next(int i, pg8::Unit& u) const {
        const long L = (long)i * G + c; if (L >= (long)nrt * NC) return false;
        const int rt = (int)(L / NC), ct = (int)(L % NC); u.pm = rt; u.pn = ct; u.aux = i; u.A = A + (size_t)rt * tA; u.B = B + (size_t)rt2e[rt] * eB + (size_t)ct * tB; return true;
    }
};
struct MoeGatherOrder {
    static constexpr bool GATHER = true;
    int G, c, NC, nrt; const char* A; const char* B; size_t tB, eB; const LAS int* rt2e; const LAS int* rowtok; unsigned rowbytes;
    __device__ bool next(int i, pg8::Unit& u) const {
        const long L = (long)i * G + c; if (L >= (long)nrt * NC) return false;
        const int rt = (int)(L / NC), ct = (int)(L % NC); u.pm = rt; u.pn = ct; u.aux = i; u.A = A; u.B = B + (size_t)rt2e[rt] * eB + (size_t)ct * tB; return true;
    }
    __device__ __forceinline__ unsigned row_off(const pg8::Unit& u, int R) const { return (unsigned)rowtok[u.aux * 256 + R] * rowbytes; }
};

struct Frame {
    LAS unsigned char* lds;
    int tid, lane, wave, G, bid;
    unsigned char* ws; float* out;
    gu32* ctl;
};
__device__ __forceinline__ const void* ldp(LAS unsigned char* lds, int k) {
    const u32x2 w = *(const LAS u32x2*)(lds + PTR_OFF + 8 * k);
    const unsigned long long a = ((unsigned long long)(unsigned)__builtin_amdgcn_readfirstlane((int)w.y) << 32) | (unsigned)__builtin_amdgcn_readfirstlane((int)w.x);
    return (const void*)a;
}
#define INF(k) ((const float*)ldp(F.lds, (k)))
#define WSP(T, off) ((T*)(F.ws + (off)))
#define WSW(T, off, l) ((T*)(F.ws + (off) + (size_t)((l) & 1) * WS_SET1_DELTA))

__device__ __forceinline__ bf16x8 frag_rm(const LAS bf16_t* base, int stride, int row0, int k0, int lane) { return *(const LAS bf16x8*)(base + (row0 + (lane & 15)) * stride + k0 + 8 * (lane >> 4)); }
__device__ __forceinline__ bf16x8 frag_tr(const LAS bf16_t* base, int stride, int k0, int n0, int lane) {
    const int g = lane >> 4, i = lane & 15; const LAS bf16_t* p = base + (k0 + 8 * g + (i >> 2)) * stride + n0 + 4 * (i & 3);
    const s16x4 a = __builtin_bit_cast(s16x4, __builtin_amdgcn_ds_read_tr16_b64_v4i16((LAS s16x4*)p));
    const s16x4 b = __builtin_bit_cast(s16x4, __builtin_amdgcn_ds_read_tr16_b64_v4i16((LAS s16x4*)(p + 4 * stride)));
    return (bf16x8){a[0], a[1], a[2], a[3], b[0], b[1], b[2], b[3]};
}
#define MFMA16(a, b, c) __builtin_amdgcn_mfma_f32_16x16x32_bf16((a), (b), (c), 0, 0, 0)

template <class Map>
__device__ __forceinline__ void convert_wT(const Frame& F, const Map& mp, int nmat, int K, int Ndst, bf16_t* dst, size_t dst_mat_stride, int ldd, int koff, int gw, int NGW) {
    LAS float* scr = (LAS float*)(F.lds + F.wave * 9216);
    const int lane = F.lane;
    const int nbk = Ndst / 32, per = (K / 64) * nbk, items = nmat * per;
    for (int it = gw; it < items; it += NGW) {
        const int e = it / per, r = it % per, kb = r / nbk, nb = r % nbk, k0 = 64 * kb, n0 = 32 * nb;
        const float* cp = mp.colptr(e, n0 + (lane & 31)); const int ld = mp.ld;
#pragma unroll 8
        for (int i = 0; i < 32; ++i) { const int kk = 2 * i + (lane >> 5); scr[kk * 33 + (lane & 31)] = cp ? cp[(size_t)(k0 + kk) * ld] : 0.f; }
        LDS_WAIT();
        const int c = lane & 7;
#pragma unroll
        for (int j = 0; j < 4; ++j) { const int n = (lane >> 3) + 8 * j; const LAS float* s = scr + (8 * c) * 33 + n;
            u32x4 o; o.x = pk2(s[0 * 33], s[1 * 33]); o.y = pk2(s[2 * 33], s[3 * 33]); o.z = pk2(s[4 * 33], s[5 * 33]); o.w = pk2(s[6 * 33], s[7 * 33]);
            *(u32x4*)(dst + (size_t)e * dst_mat_stride + (size_t)(n0 + n) * ldd + koff + k0 + 8 * c) = o; }
        LDS_WAIT();
    }
}
template <class Map>
__device__ __forceinline__ void convert_wT4(const Frame& F, const Map& mp, int nmat, int K, int Ndst, bf16_t* dst, size_t dst_mat_stride, int ldd, int koff, int& rot, int gw0, int NGW) {
    LAS bf16_t* tl = (LAS bf16_t*)(F.lds + F.wave * 9216);
    const int lane = F.lane;
    const int nbk = Ndst / 64, per = (K / 64) * nbk, items = nmat * per;
    int gw = (gw0 + NGW - (rot % NGW)) % NGW; rot += items;
    const int c4 = (lane & 15) * 4, r4 = lane >> 4;
#define CV_LOAD(arr, it_) do { const int e_ = (it_) / per, r_ = (it_) % per, k0_ = 64 * (r_ / nbk), n0_ = 64 * (r_ % nbk); const float* cp_ = mp.colptr(e_, n0_ + c4); \
        _Pragma("unroll") for (int i = 0; i < 16; ++i) arr[i] = cp_ ? __builtin_nontemporal_load((const f32x4*)(cp_ + (size_t)(k0_ + 4 * i + r4) * mp.ld)) : (f32x4){0.f, 0.f, 0.f, 0.f}; } while (0)
#define CV_PROC(arr, it_) do { const int e_ = (it_) / per, r_ = (it_) % per, k0_ = 64 * (r_ / nbk), n0_ = 64 * (r_ % nbk); \
        _Pragma("unroll") for (int i = 0; i < 16; ++i) { u32x2 w_; w_.x = pk2(arr[i][0], arr[i][1]); w_.y = pk2(arr[i][2], arr[i][3]); *(LAS u32x2*)(tl + (4 * i + r4) * 72 + c4) = w_; } \
        LDS_WAIT(); \
        bf16_t* db_ = dst + (size_t)e_ * dst_mat_stride + (size_t)(n0_ + (lane & 15)) * ldd + koff + k0_ + 8 * (lane >> 4); \
        _Pragma("unroll") for (int kk = 0; kk < 2; ++kk) _Pragma("unroll") for (int nn = 0; nn < 4; ++nn) { const bf16x8 o_ = frag_tr(tl, 72, 32 * kk, 16 * nn, lane); *(bf16x8*)(db_ + (size_t)(16 * nn) * ldd + 32 * kk) = o_; } \
        LDS_WAIT(); } while (0)
    f32x4 va[16], vb[16], vc[16];
    int it = gw;
    if (it < items) CV_LOAD(va, it);
    if (it + NGW < items) CV_LOAD(vb, it + NGW);
    while (it < items) {
        if (it + 2 * NGW < items) CV_LOAD(vc, it + 2 * NGW);
        CV_PROC(va, it); it += NGW; if (it >= items) break;
        if (it + 2 * NGW < items) CV_LOAD(va, it + 2 * NGW);
        CV_PROC(vb, it); it += NGW; if (it >= items) break;
        if (it + 2 * NGW < items) CV_LOAD(vb, it + 2 * NGW);
        CV_PROC(vc, it); it += NGW;
    }
#undef CV_LOAD
#undef CV_PROC
}
template <class Map>
__device__ __forceinline__ void convert_wT4_fp8(const Frame& F, const Map& mp, int K, int Ndst, unsigned char* dst, int ldd, int& rot, int gw0, int NGW) {
    LAS bf16_t* tl = (LAS bf16_t*)(F.lds + F.wave * 9216);
    const int lane = F.lane;
    const int nbk = Ndst / 64, items = (K / 64) * nbk;
    int gw = (gw0 + NGW - (rot % NGW)) % NGW; rot += items;
    const int c4 = (lane & 15) * 4, r4 = lane >> 4;
    for (int it = gw; it < items; it += NGW) {
        const int k0 = 64 * (it / nbk), n0 = 64 * (it % nbk); const float* cp = mp.colptr(0, n0 + c4);
        f32x4 v[16];
#pragma unroll
        for (int i = 0; i < 16; ++i) v[i] = cp ? __builtin_nontemporal_load((const f32x4*)(cp + (size_t)(k0 + 4 * i + r4) * mp.ld)) : (f32x4){0.f, 0.f, 0.f, 0.f};
#pragma unroll
        for (int i = 0; i < 16; ++i) { u32x2 w_; w_.x = pk2(v[i][0] * 64.f, v[i][1] * 64.f); w_.y = pk2(v[i][2] * 64.f, v[i][3] * 64.f); *(LAS u32x2*)(tl + (4 * i + r4) * 72 + c4) = w_; }
        LDS_WAIT();
        unsigned char* db = dst + (size_t)(n0 + (lane & 15)) * ldd + k0 + 8 * (lane >> 4);
#pragma unroll
        for (int kk = 0; kk < 2; ++kk)
#pragma unroll
            for (int nn = 0; nn < 4; ++nn) { const bf16x8 o = frag_tr(tl, 72, 32 * kk, 16 * nn, lane); const u32x4 ow = __builtin_bit_cast(u32x4, o); float f[8]; unpack8(ow, f);
                st8_fp8(db + (size_t)(16 * nn) * ldd + 32 * kk, f); }
        LDS_WAIT();
    }
}
struct MapIdent { const float* W; int ld; size_t mstride; __device__ const float* colptr(int e, int n) const { return W + (size_t)e * mstride + n; } };
struct MapWin { const float* W; int ld; int noff;
    __device__ const float* colptr(int, int n_) const {
        const int n = n_ + noff; int s;
        if (n < 1024) s = n; else if (n < 2560) s = 1728 + (n - 1024); else if (n < 4096) s = 3280 + (n - 2560); else if (n < 12288) s = 4824 + (n - 4096);
        else if (n < 12992) s = 1024 + (n - 12288); else if (n < 13008) s = 3264 + (n - 12992); else if (n < 13016) s = 4816 + (n - 13008); else return nullptr;
        return W + s; } };
struct MapUq { const float* W; int ld;
    __device__ const float* colptr(int, int n) const { const int h = n / 192, j = n % 192; if (j < 128) return W + n; const int jj = j - 128, i = jj >> 1; return W + h * 192 + 128 + ((jj & 1) ? 32 + i : i); } };
struct MapGU { const float* Wg; const float* Wu; int ld;
    __device__ const float* colptr(int e, int n) const { const int q = n >> 5, i = n & 31; const long long d = (const char*)Wu - (const char*)Wg;
        return (const float*)((const char*)Wg + (((i >> 2) & 1) ? d : 0ll)) + (size_t)e * 2048 * 512 + 16 * q + 4 * (i >> 3) + (i & 3); } };
__device__ __forceinline__ void phase_convert(const Frame& F, int l, int part, int gw, int NGW) {
    int rot = 0;
    if (part & 1) {
        { MapWin mp{INF(5) + (size_t)l * DM * DIN, DIN, 0}; convert_wT4_fp8(F, mp, DM, 4096, WSW(unsigned char, WS_WIN, l), DM, rot, gw, NGW); }
        { MapWin mp{INF(5) + (size_t)l * DM * DIN, DIN, 12288}; convert_wT4_fp8(F, mp, DM, 768, WSW(unsigned char, WS_WIN, l) + (size_t)12288 * DM, DM, rot, gw, NGW); }
        { MapIdent mp{INF(5) + (size_t)l * DM * DIN + 4824, DIN, 0}; convert_wT4_fp8(F, mp, DM, 8192, WSW(unsigned char, WS_WG8, l), DM, rot, gw, NGW); }
    }
    if (part & 4) {
#pragma unroll 1
        for (int e = 0; e < 16; ++e) { MapIdent mp{INF(34) + ((size_t)l * 16 + e) * 512 * DM, DM, 0}; convert_wT4_fp8(F, mp, 512, DM, WSW(unsigned char, WS_WD, l) + (size_t)e * DM * 512, 512, rot, gw, NGW); } }
    if (part & 2) {
#pragma unroll 1
        for (int e = 0; e < 16; ++e) { MapGU mp{INF(32) + ((size_t)l * 16 + e) * DM * 512, INF(33) + ((size_t)l * 16 + e) * DM * 512, 512}; convert_wT4_fp8(F, mp, DM, 1024, WSW(unsigned char, WS_WGU, l) + (size_t)e * 1024 * DM, DM, rot, gw, NGW); }
#pragma unroll 1
        for (int n = 0; n < 4; ++n) { MapIdent mp{INF(21) + ((size_t)l * 4 + n) * 512 * DM, DM, 0}; convert_wT4_fp8(F, mp, 512, DM, WSW(unsigned char, WS_WBR, l) + n * 512, DM, rot, gw, NGW); }
        { MapIdent mp{INF(22) + (size_t)l * DM * DM, DM, 0}; convert_wT4_fp8(F, mp, DM, DM, WSW(unsigned char, WS_WOUT, l), DM, rot, gw, NGW); }
        { MapIdent mp{INF(25) + (size_t)l * DM * 512, 512, 0}; convert_wT4_fp8(F, mp, DM, 512, WSW(unsigned char, WS_WXQ, l), DM, rot, gw, NGW); }
        { MapIdent mp{INF(26) + (size_t)l * DM * 1024, 1024, 0}; convert_wT4_fp8(F, mp, DM, 1024, WSW(unsigned char, WS_WXKV, l), DM, rot, gw, NGW); }
        { MapIdent mp{INF(27) + (size_t)l * 512 * DM, DM, 0}; convert_wT4_fp8(F, mp, 512, DM, WSW(unsigned char, WS_WXO, l), 512, rot, gw, NGW); }
        { MapIdent mp{INF(13) + (size_t)l * 256 * 1024, 1024, 0}; convert_wT4(F, mp, 1, 256, 1024, WSW(bf16_t, WS_WUKV, l), 0, 256, 0, rot, gw, NGW); }
        { MapUq mp{INF(12) + (size_t)l * 384 * 768, 768}; convert_wT(F, mp, 1, 384, 768, WSW(bf16_t, WS_WUQ, l), 0, 384, 0, gw, NGW); }
    }
}

__device__ __forceinline__ void moe_offsets(const Frame& F, int l, LAS int* off  , LAS int* rt2e  ) {
    __syncthreads();
    if (F.tid < 16) off[128 + F.tid] = (int)__hip_atomic_load((const unsigned*)(F.ctl + CW_CNT + 64 * l) + F.tid, __ATOMIC_RELAXED, __HIP_MEMORY_SCOPE_AGENT);
    __syncthreads();
    if (F.tid == 0) { int o = 0;
        for (int e = 0; e < 16; ++e) { off[e] = o; const int n = off[128 + e]; const int nr = (n + 255) >> 8; for (int r = 0; r < nr; ++r) rt2e[(o >> 8) + r] = e; o += nr << 8; }
        off[16] = o; }
    __syncthreads();
}
struct LnRaw { u32x4 a[4], b[4], c[4]; };
template <int MODE>
__device__ __forceinline__ void ln_load(const Frame& F, LnRaw& r, const float* src, int m, int lane, int row0, int row1) {
    if (MODE == 0) {
#pragma unroll
        for (int j = 0; j < 4; ++j) { r.a[j] = *(const u32x4*)(src + (size_t)m * DM + lane * 8 + 512 * j); r.b[j] = *(const u32x4*)(src + (size_t)m * DM + lane * 8 + 512 * j + 4); }
    } else if (MODE == 1) { const bf16_t* hT = WSP(bf16_t, WS_HT);
#pragma unroll
        for (int j = 0; j < 4; ++j) r.a[j] = *(const u32x4*)(hT + (size_t)m * DM + lane * 8 + 512 * j);
    } else { const bf16_t* hB = WSP(bf16_t, WS_HB); const unsigned char* yd = WSP(unsigned char, WS_YD);
#pragma unroll
        for (int j = 0; j < 4; ++j) { r.a[j] = __builtin_nontemporal_load((const u32x4*)(hB + (size_t)m * DM + lane * 8 + 512 * j)); const u32x2 b_ = __builtin_nontemporal_load((const u32x2*)(yd + (size_t)row0 * DM + lane * 8 + 512 * j)), c_ = __builtin_nontemporal_load((const u32x2*)(yd + (size_t)row1 * DM + lane * 8 + 512 * j));
            r.b[j].x = b_.x; r.b[j].y = b_.y; r.c[j].x = c_.x; r.c[j].y = c_.y; }
    }
}
template <int MODE, bool WF32, bool FINAL>
__device__ __forceinline__ void ln_rows(const Frame& F, const float* src, const float* g, const float* b, int l) {
    float* hF = WSP(float, WS_HF); bf16_t* hB = WSP(bf16_t, WS_HB);
    const int gw = F.bid * NWAVES + F.wave, NGW = F.G * NWAVES, lane = F.lane;
    const LAS int* off = (const LAS int*)(F.lds + MOE_TAB_OFF); const int* tkb = WSP(int, WS_TOK);
    if (MODE == 2) { moe_offsets(F, l, (LAS int*)(F.lds + MOE_TAB_OFF), (LAS int*)(F.lds + MOE_TAB_OFF) + 32); }
    int r0n = 0, r1n = 0, r0nn = 0, r1nn = 0;
    if (MODE == 2) { if (gw < NT) { const int* tk = tkb + (size_t)gw * 8; r0n = off[tk[0]] + tk[2]; r1n = off[tk[1]] + tk[3]; } }
    f32x4 gv[4][2], bv[4][2];
#pragma unroll
    for (int j = 0; j < 4; ++j) { const int c0 = lane * 8 + 512 * j; gv[j][0] = *(const f32x4*)(g + c0); gv[j][1] = *(const f32x4*)(g + c0 + 4); bv[j][0] = *(const f32x4*)(b + c0); bv[j][1] = *(const f32x4*)(b + c0 + 4); }
    LnRaw cur, nxt;
    if (gw < NT) ln_load<MODE>(F, cur, src, gw, lane, r0n, r1n);
    if (MODE == 2) { if (gw + NGW < NT) { const int* tk = tkb + (size_t)(gw + NGW) * 8; r0n = off[tk[0]] + tk[2]; r1n = off[tk[1]] + tk[3]; } }
    for (int m = gw; m < NT; m += NGW) {
        const int mn = m + NGW;
        if (mn < NT) ln_load<MODE>(F, nxt, src, mn, lane, r0n, r1n);
        if (MODE == 2) { if (mn + NGW < NT) { const int* tk = tkb + (size_t)(mn + NGW) * 8; r0nn = off[tk[0]] + tk[2]; r1nn = off[tk[1]] + tk[3]; } }
        float v[4][8]; float s = 0.f;
        if (MODE == 0) {
#pragma unroll
            for (int j = 0; j < 4; ++j) { v[j][0] = __uint_as_float(cur.a[j].x); v[j][1] = __uint_as_float(cur.a[j].y); v[j][2] = __uint_as_float(cur.a[j].z); v[j][3] = __uint_as_float(cur.a[j].w);
                v[j][4] = __uint_as_float(cur.b[j].x); v[j][5] = __uint_as_float(cur.b[j].y); v[j][6] = __uint_as_float(cur.b[j].z); v[j][7] = __uint_as_float(cur.b[j].w); }
        } else if (MODE == 1) {
#pragma unroll
            for (int j = 0; j < 4; ++j) unpack8(cur.a[j], v[j]);
        } else {
#pragma unroll
            for (int j = 0; j < 4; ++j) { float a[8], c[8]; unpack8(cur.a[j], v[j]); unpack8_fp8(cur.b[j].x, cur.b[j].y, a); unpack8_fp8(cur.c[j].x, cur.c[j].y, c);
#pragma unroll
                for (int e = 0; e < 8; ++e) v[j][e] = v[j][e] * ALPHA + (a[e] + c[e]) * (1.0f / 16.0f); }
        }
#pragma unroll
        for (int j = 0; j < 4; ++j)
#pragma unroll
            for (int e = 0; e < 8; ++e) s += v[j][e];
        const float mean = wave_sum(s, lane) * (1.f / DM); float s2 = 0.f;
#pragma unroll
        for (int j = 0; j < 4; ++j)
#pragma unroll
            for (int e = 0; e < 8; ++e) { v[j][e] -= mean; s2 += v[j][e] * v[j][e]; }
        const float rstd = __builtin_amdgcn_rsqf(wave_sum(s2, lane) * (1.f / DM) + LN_EPS);
#pragma unroll
        for (int j = 0; j < 4; ++j) { const int c0 = lane * 8 + 512 * j;
            const f32x4 g0 = gv[j][0], g1 = gv[j][1], b0 = bv[j][0], b1 = bv[j][1];
#pragma unroll
            for (int e = 0; e < 4; ++e) { v[j][e] = v[j][e] * rstd * g0[e] + b0[e]; v[j][4 + e] = v[j][4 + e] * rstd * g1[e] + b1[e]; }
            if (!FINAL) { st8(hB + (size_t)m * DM + c0, v[j]); if (MODE != 1) st8_fp8(WSP(unsigned char, WS_HB8) + (size_t)m * DM + c0, v[j]); }
            if (WF32) { *(f32x4*)(hF + (size_t)m * DM + c0) = (f32x4){v[j][0], v[j][1], v[j][2], v[j][3]}; *(f32x4*)(hF + (size_t)m * DM + c0 + 4) = (f32x4){v[j][4], v[j][5], v[j][6], v[j][7]}; }
            if (FINAL) { *(f32x4*)(F.out + (size_t)m * DM + c0) = (f32x4){v[j][0], v[j][1], v[j][2], v[j][3]}; *(f32x4*)(F.out + (size_t)m * DM + c0 + 4) = (f32x4){v[j][4], v[j][5], v[j][6], v[j][7]}; } }
        cur = nxt; r0n = r0nn; r1n = r1nn;
    }
}

__device__ __forceinline__ void phase_ln2_router(const Frame& F, const float* g, const float* b, int l) {
    bf16_t* hB = WSP(bf16_t, WS_HB); const bf16_t* hT = WSP(bf16_t, WS_HT); const bf16_t* wrt = WSP(bf16_t, WS_WRT);
    LAS unsigned char* Hhi = F.lds; LAS unsigned char* Hlo = F.lds + 65536; LAS float* part = (LAS float*)(F.lds + ROWTAB_OFF);
    const int lane = F.lane, w = F.wave, gq = lane >> 4, ic = lane & 15;
    const float* rb = INF(31);
    for (int grp = F.bid; grp < NT / 16; grp += F.G) {
        const int m0 = grp * 16;
        __syncthreads();
        u32x4 raw[2][4];
#pragma unroll
        for (int rr = 0; rr < 2; ++rr)
#pragma unroll
            for (int j = 0; j < 4; ++j) raw[rr][j] = *(const u32x4*)(hT + (size_t)(m0 + 2 * w + rr) * DM + lane * 8 + 512 * j);
#pragma unroll
        for (int rr = 0; rr < 2; ++rr) { const int r = 2 * w + rr, m = m0 + r;
            float v[4][8]; float s = 0.f;
#pragma unroll
            for (int j = 0; j < 4; ++j) unpack8(raw[rr][j], v[j]);
#pragma unroll
            for (int j = 0; j < 4; ++j)
#pragma unroll
                for (int e = 0; e < 8; ++e) s += v[j][e];
            const float mean = wave_sum(s, lane) * (1.f / DM); float s2 = 0.f;
#pragma unroll
            for (int j = 0; j < 4; ++j)
#pragma unroll
                for (int e = 0; e < 8; ++e) { v[j][e] -= mean; s2 += v[j][e] * v[j][e]; }
            const float rstd = 1.f / sqrtf(wave_sum(s2, lane) * (1.f / DM) + LN_EPS);
#pragma unroll
            for (int j = 0; j < 4; ++j) { const int c0 = lane * 8 + 512 * j;
                const f32x4 g0 = *(const f32x4*)(g + c0), g1 = *(const f32x4*)(g + c0 + 4), b0 = *(const f32x4*)(b + c0), b1 = *(const f32x4*)(b + c0 + 4);
#pragma unroll
                for (int e = 0; e < 4; ++e) { v[j][e] = v[j][e] * rstd * g0[e] + b0[e]; v[j][4 + e] = v[j][4 + e] * rstd * g1[e] + b1[e]; }
                st8(hB + (size_t)m * DM + c0, v[j]);
                unsigned hi[8], lo[8];
#pragma unroll
                for (int e = 0; e < 8; ++e) { hi[e] = f2bf(v[j][e]); lo[e] = f2bf(v[j][e] - __uint_as_float(hi[e] << 16)); }
                const int pc = ((lane + 64 * j) ^ r) * 16;
                *(LAS u32x4*)(Hhi + r * 4096 + pc) = (u32x4){hi[0] | (hi[1] << 16), hi[2] | (hi[3] << 16), hi[4] | (hi[5] << 16), hi[6] | (hi[7] << 16)};
                *(LAS u32x4*)(Hlo + r * 4096 + pc) = (u32x4){lo[0] | (lo[1] << 16), lo[2] | (lo[3] << 16), lo[4] | (lo[5] << 16), lo[6] | (lo[7] << 16)}; }
        }
        __syncthreads();
        f32x4 acc = (f32x4){0.f, 0.f, 0.f, 0.f};
#pragma unroll
        for (int ks = 0; ks < 8; ++ks) { const int k = 256 * w + 32 * ks + 8 * gq; const int pc = ((k >> 3) ^ ic) * 16;
            const bf16x8 ahi = *(const LAS bf16x8*)(Hhi + ic * 4096 + pc), alo = *(const LAS bf16x8*)(Hlo + ic * 4096 + pc);
            const bf16x8 bhi = *(const bf16x8*)(wrt + (size_t)ic * DM + k), blo = *(const bf16x8*)(wrt + (size_t)(16 + ic) * DM + k);
            acc = MFMA16(ahi, bhi, acc); acc = MFMA16(ahi, blo, acc); acc = MFMA16(alo, bhi, acc); }
#pragma unroll
        for (int r = 0; r < 4; ++r) part[(w * 16 + 4 * gq + r) * 17 + ic] = acc[r];
        __syncthreads();
        if (w == 0 && lane < 16) {
            const int m = m0 + lane;
            float aff[16], bi[16];
#pragma unroll
            for (int e = 0; e < 16; ++e) { float lg = 0.f;
#pragma unroll
                for (int q = 0; q < 8; ++q) lg += part[(q * 16 + lane) * 17 + e];
                aff[e] = 1.0f / (1.0f + expf(-lg)); bi[e] = aff[e] + rb[e]; }
            int gbest = 0; float gsc = -1e30f;
#pragma unroll
            for (int q = 0; q < 4; ++q) { float m1 = -1e30f, m2 = -1e30f;
#pragma unroll
                for (int i = 0; i < 4; ++i) { const float x = bi[4 * q + i]; if (x > m1) { m2 = m1; m1 = x; } else if (x > m2) m2 = x; }
                const float sc = m1 + m2; if (sc > gsc) { gsc = sc; gbest = q; } }
            int i0 = 0, i1 = 0; float b0 = -1e30f, b1 = -1e30f;
#pragma unroll
            for (int q = 0; q < 4; ++q) if (q == gbest) {
#pragma unroll
                for (int i = 0; i < 4; ++i) { const float x = bi[4 * q + i]; if (x > b0) { b1 = b0; i1 = i0; b0 = x; i0 = i; } else if (x > b1) { b1 = x; i1 = i; } } }
            float a0 = 0.f, a1 = 0.f;
#pragma unroll
            for (int e = 0; e < 16; ++e) { if (e == gbest * 4 + i0) a0 = aff[e]; if (e == gbest * 4 + i1) a1 = aff[e]; }
            const int e0 = gbest * 4 + i0, e1 = gbest * 4 + i1; const float inv = 1.0f / (a0 + a1);
            unsigned* cnt = (unsigned*)(F.ctl + CW_CNT + 64 * l);
            const unsigned p0 = atomicAdd(cnt + e0, 1u), p1 = atomicAdd(cnt + e1, 1u);
            int* tk = WSP(int, WS_TOK) + (size_t)m * 8;
            tk[0] = e0; tk[1] = e1; tk[2] = (int)p0; tk[3] = (int)p1; tk[6] = __float_as_int(a0 * inv); tk[7] = __float_as_int(a1 * inv);
        }
    }
}


__device__ __forceinline__ void phase_router(const Frame& F, int l) {
    const bf16_t* hB = WSP(bf16_t, WS_HB); const bf16_t* wrt = WSP(bf16_t, WS_WRT);
    LAS float* part = (LAS float*)F.lds;
    const int lane = F.lane, w = F.wave, gq = lane >> 4, ic = lane & 15;
    const float* rb = INF(31);
    for (int t2 = F.bid; t2 < NT / 32; t2 += F.G) {
        const int m0 = (t2 * 2 + (w >> 2)) * 16, kbase = (w & 3) * 512;
        f32x4 acc = (f32x4){0.f, 0.f, 0.f, 0.f};
#pragma unroll 8
        for (int ks = 0; ks < 16; ++ks) { const int k = kbase + 32 * ks + 8 * gq;
            const bf16x8 a = *(const bf16x8*)(hB + (size_t)(m0 + ic) * DM + k);
            const bf16x8 bhi = *(const bf16x8*)(wrt + (size_t)ic * DM + k), blo = *(const bf16x8*)(wrt + (size_t)(16 + ic) * DM + k);
            acc = MFMA16(a, bhi, acc); acc = MFMA16(a, blo, acc); }
        __syncthreads();
#pragma unroll
        for (int r = 0; r < 4; ++r) part[(w * 16 + 4 * gq + r) * 17 + ic] = acc[r];
        __syncthreads();
        if ((w & 3) == 0 && lane < 16) {
            const int m = m0 + lane;
            float aff[16], bi[16];
#pragma unroll
            for (int e = 0; e < 16; ++e) { float lg = 0.f;
#pragma unroll
                for (int q = 0; q < 4; ++q) lg += part[((w + q) * 16 + lane) * 17 + e];
                aff[e] = 1.0f / (1.0f + expf(-lg)); bi[e] = aff[e] + rb[e]; }
            int gbest = 0; float gsc = -1e30f;
#pragma unroll
            for (int q = 0; q < 4; ++q) { float m1 = -1e30f, m2 = -1e30f;
#pragma unroll
                for (int i = 0; i < 4; ++i) { const float x = bi[4 * q + i]; if (x > m1) { m2 = m1; m1 = x; } else if (x > m2) m2 = x; }
                const float sc = m1 + m2; if (sc > gsc) { gsc = sc; gbest = q; } }
            int i0 = 0, i1 = 0; float b0 = -1e30f, b1 = -1e30f;
#pragma unroll
            for (int q = 0; q < 4; ++q) if (q == gbest) {
#pragma unroll
                for (int i = 0; i < 4; ++i) { const float x = bi[4 * q + i]; if (x > b0) { b1 = b0; i1 = i0; b0 = x; i0 = i; } else if (x > b1) { b1 = x; i1 = i; } } }
            float a0 = 0.f, a1 = 0.f;
#pragma unroll
            for (int e = 0; e < 16; ++e) { if (e == gbest * 4 + i0) a0 = aff[e]; if (e == gbest * 4 + i1) a1 = aff[e]; }
            const int e0 = gbest * 4 + i0, e1 = gbest * 4 + i1; const float inv = 1.0f / (a0 + a1);
            unsigned* cnt = (unsigned*)(F.ctl + CW_CNT + 64 * l);
            const unsigned p0 = atomicAdd(cnt + e0, 1u), p1 = atomicAdd(cnt + e1, 1u);
            int* tk = WSP(int, WS_TOK) + (size_t)m * 8;
            tk[0] = e0; tk[1] = e1; tk[2] = (int)p0; tk[3] = (int)p1; tk[6] = __float_as_int(a0 * inv); tk[7] = __float_as_int(a1 * inv);
        }
    }
}

__device__ __forceinline__ void phase_p0(const Frame& F) {
    phase_convert(F, 0, 7, F.bid * NWAVES + F.wave, F.G * NWAVES);
    ln_rows<0, false, false>(F, INF(0), INF(3), INF(4), 0);
    const int gt = F.bid * NTHREADS + F.tid, NGT = F.G * NTHREADS;
    const float* mem = INF(1); unsigned char* mb = WSP(unsigned char, WS_MEMB);
    for (int i = gt; i < NMEM * DM / 4; i += NGT) { const f32x4 v = *(const f32x4*)(mem + (size_t)i * 4); *(unsigned*)(mb + (size_t)i * 4) = pk_fp8x4(v[0], v[1], v[2], v[3]); }
    { const float* W = INF(30); bf16_t* wrt = WSP(bf16_t, WS_WRT);
      for (int i = gt; i < DM * 16; i += NGT) { const int k = i >> 4, e = i & 15; const float x = W[i]; const unsigned hi = f2bf(x); const float xl = x - __uint_as_float(hi << 16);
          wrt[(size_t)e * DM + k] = (bf16_t)hi; wrt[(size_t)(16 + e) * DM + k] = (bf16_t)f2bf(xl); } }
    const int* pos = (const int*)ldp(F.lds, 2); f32x2* cs = WSP(f32x2, WS_CS);
    for (int i = gt; i < NT * 32; i += NGT) { const int m = i >> 5, k = i & 31; const float fr = exp2f(-(float)k * (13.287712379549449f / 32.0f)); const float a = (float)pos[m] * fr; cs[i] = (f32x2){cosf(a), sinf(a)}; }
}

__device__ __forceinline__ void phase_tokprep(const Frame& F, int l) {
    constexpr int TB = 1;
    const int gw = F.bid * NWAVES + F.wave, NGW = F.G * NWAVES, lane = F.lane;
    const bf16_t* Z = WSP(bf16_t, WS_Z);
    const float* vg = INF(6) + l * 512, *vb = INF(7) + l * 512, *qg = INF(10) + l * 384, *kvg = INF(11) + l * 256;
    const float* wgate = INF(14) + l * 16 * 256, *bgate = INF(15) + l * 256, *cw = INF(17) + l * 4 * 512, *cb = INF(18) + l * 512, *gb = INF(19) + l * 8;
    const f32x2* cs = WSP(f32x2, WS_CS);
    f32x4 wg[16], cwv[4][2];
#pragma unroll
    for (int r = 0; r < 16; ++r) wg[r] = *(const f32x4*)(wgate + r * 256 + lane * 4);
#pragma unroll
    for (int k = 0; k < 4; ++k) { cwv[k][0] = *(const f32x4*)(cw + k * 512 + lane * 8); cwv[k][1] = *(const f32x4*)(cw + k * 512 + lane * 8 + 4); }
    const f32x4 bg = *(const f32x4*)(bgate + lane * 4), cb0 = *(const f32x4*)(cb + lane * 8), cb1 = *(const f32x4*)(cb + lane * 8 + 4);
    const f32x4 vg0 = *(const f32x4*)(vg + lane * 8), vg1 = *(const f32x4*)(vg + lane * 8 + 4), vb0 = *(const f32x4*)(vb + lane * 8), vb1 = *(const f32x4*)(vb + lane * 8 + 4);
    const f32x4 qg0 = *(const f32x4*)(qg + (lane < 48 ? lane : 0) * 8), qg1 = *(const f32x4*)(qg + (lane < 48 ? lane : 0) * 8 + 4), kg0 = *(const f32x4*)(kvg + (lane & 31) * 8), kg1 = *(const f32x4*)(kvg + (lane & 31) * 8 + 4);
    const float gbl = gb[lane & 7];
    for (int m0 = gw; m0 < NT; m0 += TB * NGW) {
        int mm[TB]; bool ok[TB];
#pragma unroll
        for (int t = 0; t < TB; ++t) { mm[t] = m0 + t * NGW; ok[t] = mm[t] < NT; if (!ok[t]) mm[t] = m0; }
        u32x4 rv[TB], rq[TB], rk[TB], rl0[TB], rl1[TB], cr[TB][4]; unsigned short k1[TB], k2[TB], gz[TB]; f32x2 cc[TB];
        const u32x4 zero4 = (u32x4){0u, 0u, 0u, 0u};
#pragma unroll
        for (int t = 0; t < TB; ++t) { const bf16_t* z = Z + (size_t)mm[t] * ZLD;
            rv[t] = __builtin_nontemporal_load((const u32x4*)(z + Z_SGV + lane * 8));
            rq[t] = (lane < 48) ? __builtin_nontemporal_load((const u32x4*)(z + Z_CQ + lane * 8)) : zero4;
            rk[t] = (lane < 32) ? __builtin_nontemporal_load((const u32x4*)(z + Z_CKV + lane * 8)) : zero4;
            rl0[t] = *(const u32x4*)(z + Z_LR); rl1[t] = *(const u32x4*)(z + Z_LR + 8);
            k1[t] = z[Z_KR + (lane & 31)]; k2[t] = z[Z_KR + 32 + (lane & 31)]; cc[t] = cs[(size_t)mm[t] * 32 + (lane & 31)]; gz[t] = z[Z_IF + (lane & 7)];
#pragma unroll
            for (int k = 0; k < 4; ++k) cr[t][k] = ((mm[t] & (SEQ - 1)) - 3 + k >= 0) ? *(const u32x4*)(z + (long)(k - 3) * ZLD + Z_MQK + lane * 8) : zero4; }
        float red[TB][4]; float xv[TB][8], xq[TB][8], xk[TB][8];
#pragma unroll
        for (int t = 0; t < TB; ++t) { unpack8(rv[t], xv[t]); unpack8(rq[t], xq[t]); unpack8(rk[t], xk[t]); red[t][0] = red[t][1] = red[t][2] = red[t][3] = 0.f;
#pragma unroll
            for (int j = 0; j < 8; ++j) { red[t][0] += xv[t][j]; red[t][1] += xv[t][j] * xv[t][j]; red[t][2] += xq[t][j] * xq[t][j]; red[t][3] += xk[t][j] * xk[t][j]; } }
#pragma unroll
        for (int o = 1; o < 64; o <<= 1)
#pragma unroll
            for (int t = 0; t < TB; ++t)
#pragma unroll
                for (int i = 0; i < 4; ++i) red[t][i] += shx(red[t][i], o, lane);
#pragma unroll
        for (int t = 0; t < TB; ++t) { if (!ok[t]) continue; const int m = mm[t];
            {
                const float mean = red[t][0] * (1.f / 512.f), var = fmaxf(red[t][1] * (1.f / 512.f) - mean * mean, 0.f), rstd = __builtin_amdgcn_rsqf(var + LN_EPS); float x[8];
#pragma unroll
                for (int j = 0; j < 4; ++j) { x[j] = (xv[t][j] - mean) * rstd * vg0[j] + vb0[j]; x[4 + j] = (xv[t][4 + j] - mean) * rstd * vg1[j] + vb1[j]; }
                st8(WSP(bf16_t, WS_VN) + (size_t)m * 512 + lane * 8, x); }
            if (lane < 48) { const float r = __builtin_amdgcn_rsqf(red[t][2] * (1.f / 384.f) + LN_EPS); float x[8];
#pragma unroll
                for (int j = 0; j < 4; ++j) { x[j] = xq[t][j] * r * qg0[j]; x[4 + j] = xq[t][4 + j] * r * qg1[j]; }
                st8(WSP(bf16_t, WS_CQN) + (size_t)m * 384 + lane * 8, x); }
            if (lane < 32) { const float r2 = __builtin_amdgcn_rsqf(red[t][3] * (1.f / 256.f) + LN_EPS); float x[8];
#pragma unroll
                for (int j = 0; j < 4; ++j) { x[j] = xk[t][j] * r2 * kg0[j]; x[4 + j] = xk[t][4 + j] * r2 * kg1[j]; }
                st8(WSP(bf16_t, WS_CKVN) + (size_t)m * 256 + lane * 8, x); }
            if (lane < 32) {
                const float x1 = bf2f(k1[t]), x2 = bf2f(k2[t]); const f32x2 c = cc[t];
                *(unsigned*)(WSP(bf16_t, WS_KR) + (size_t)m * 64 + 2 * lane) = pk2(x1 * c.x - x2 * c.y, x1 * c.y + x2 * c.x); }
            {
                float lr[16]; unpack8(rl0[t], lr); unpack8(rl1[t], lr + 8);
                f32x4 a = bg;
#pragma unroll
                for (int r = 0; r < 16; ++r) a += wg[r] * lr[r];
                f32x4 o;
#pragma unroll
                for (int j = 0; j < 4; ++j) o[j] = logsigmoidf_(a[j]) * (1.f / 16.f);
                *(f32x4*)(WSP(float, WS_LOGA) + (size_t)m * 256 + lane * 4) = o; }
            {
                float a[8];
#pragma unroll
                for (int j = 0; j < 4; ++j) { a[j] = cb0[j]; a[4 + j] = cb1[j]; }
#pragma unroll
                for (int k = 0; k < 4; ++k) { float x[8]; unpack8(cr[t][k], x);
#pragma unroll
                    for (int j = 0; j < 4; ++j) { a[j] += cwv[k][0][j] * x[j]; a[4 + j] += cwv[k][1][j] * x[4 + j]; } }
                const float sc = (lane < 32) ? 0.125f : 1.0f;
#pragma unroll
                for (int j = 0; j < 8; ++j) a[j] = siluf_(a[j]) * sc;
                bf16_t* dst = (lane < 32) ? (WSP(bf16_t, WS_MQ) + (size_t)m * 256 + lane * 8) : (WSP(bf16_t, WS_MK) + (size_t)m * 256 + (lane - 32) * 8);
                st8(dst, a); }
            if (lane < 8) { const float x = bf2f(gz[t]) + gbl; WSP(float, WS_GIF)[(size_t)m * 8 + lane] = (lane < 4) ? x : logsigmoidf_(x); }
        }
    }
}

__device__ __forceinline__ void sg_item(const Frame& F, int l, int item) {
    const int c = item >> 2, g = item & 3, m0 = c * 128, lane = F.lane, w = F.wave;
    LAS bf16_t* vt = (LAS bf16_t*)F.lds;
    const bf16_t* vn = WSP(bf16_t, WS_VN);
    __syncthreads();
    for (int i = F.tid; i < 128 * 16; i += NTHREADS) { const int s = i >> 4, ch = i & 15; *(LAS u32x4*)(vt + s * 136 + ch * 8) = *(const u32x4*)(vn + (size_t)(m0 + s) * 512 + g * 128 + ch * 8); }
    __syncthreads();
    const float* W = INF(8) + ((size_t)(l * 4 + g) * 128) * 128; const float* bs = INF(9) + (l * 4 + g) * 128;
    const int t = 16 * w + (lane & 15), gq = lane >> 4;
    f32x4 acc[8];
#pragma unroll
    for (int mt = 0; mt < 8; ++mt) acc[mt] = (f32x4){0.f, 0.f, 0.f, 0.f};
    for (int ks = 0; ks < 4; ++ks) {
        if (32 * ks > 16 * w + 15) break;
        const int s0 = 32 * ks + 8 * gq; const f32x4 w0 = *(const f32x4*)(W + (size_t)t * 128 + s0), w1 = *(const f32x4*)(W + (size_t)t * 128 + s0 + 4);
        float wv[8] = {w0[0], w0[1], w0[2], w0[3], w1[0], w1[1], w1[2], w1[3]};
#pragma unroll
        for (int j = 0; j < 8; ++j) if (s0 + j > t) wv[j] = 0.f;
        const u32x4 pw = (u32x4){pk2(wv[0], wv[1]), pk2(wv[2], wv[3]), pk2(wv[4], wv[5]), pk2(wv[6], wv[7])};
        const bf16x8 bfr = __builtin_bit_cast(bf16x8, pw);
#pragma unroll
        for (int mt = 0; mt < 8; ++mt) { const bf16x8 a = frag_tr(vt, 136, 32 * ks, 16 * mt, lane); acc[mt] = MFMA16(a, bfr, acc[mt]); }
    }
    const float bias = bs[t]; const bf16_t* zu = WSP(bf16_t, WS_Z) + (size_t)(m0 + t) * ZLD + Z_SGU + g * 128; unsigned char* yo = WSP(unsigned char, WS_YC8) + (size_t)(m0 + t) * DM + g * 128;
#pragma unroll
    for (int mt = 0; mt < 8; ++mt) { const int d = 16 * mt + 4 * gq; const u32x2 uu = *(const u32x2*)(zu + d);
        f32x4 o; o[0] = lo_bf(uu.x) * (acc[mt][0] + bias); o[1] = hi_bf(uu.x) * (acc[mt][1] + bias); o[2] = lo_bf(uu.y) * (acc[mt][2] + bias); o[3] = hi_bf(uu.y) * (acc[mt][3] + bias);
        *(unsigned*)(yo + d) = pk_fp8x4(o[0], o[1], o[2], o[3]); }
}

__device__ __forceinline__ void gla_cumsum(const Frame& F, LAS float* bt, LAS float* seg, const float* la  ) {
    const int tid = F.tid;
    { const int t = tid >> 3, d8 = (tid & 7) * 8; const f32x4 a = *(const f32x4*)(la + (size_t)t * 256 + d8), b = *(const f32x4*)(la + (size_t)t * 256 + d8 + 4);
      LAS float* p = bt + t * 65 + d8; p[0] = a[0]; p[1] = a[1]; p[2] = a[2]; p[3] = a[3]; p[4] = b[0]; p[5] = b[1]; p[6] = b[2]; p[7] = b[3]; }
    __syncthreads();
    const int d = tid & 63, sg = tid >> 6; float run = 0.f;
#pragma unroll
    for (int j = 0; j < 8; ++j) { run += bt[(sg * 8 + j) * 65 + d]; bt[(sg * 8 + j) * 65 + d] = run; }
    seg[sg * 64 + d] = run;
    __syncthreads();
    float pre = 0.f;
    for (int q = 0; q < sg; ++q) pre += seg[q * 64 + d];
#pragma unroll
    for (int j = 0; j < 8; ++j) bt[(sg * 8 + j) * 65 + d] += pre;
    __syncthreads();
}
__device__ __forceinline__ void gla_pass1(const Frame& F, int item) {
    const int bh = item >> 5, c = item & 31, b = bh >> 2, h = bh & 3, m0 = b * SEQ + c * 64, tid = F.tid, lane = F.lane, w = F.wave;
    LAS float* bt = (LAS float*)F.lds; LAS float* seg = (LAS float*)(F.lds + 16896);
    LAS bf16_t* kd = (LAS bf16_t*)(F.lds + 19456); LAS bf16_t* vt = (LAS bf16_t*)(F.lds + 19456 + 9216);
    const bf16_t* Z = WSP(bf16_t, WS_Z);
    __syncthreads();
    const int s_ = tid >> 3, d8_ = (tid & 7) * 8;
    const u32x4 rk = *(const u32x4*)(Z + (size_t)(m0 + s_) * ZLD + Z_GK + h * 64 + d8_); u32x4 rv[2];
#pragma unroll
    for (int q = 0; q < 2; ++q) { const int ch = (tid & 7) + 8 * q; rv[q] = *(const u32x4*)(Z + (size_t)(m0 + s_) * ZLD + Z_GV + h * 128 + ch * 8); }
    gla_cumsum(F, bt, seg, WSP(float, WS_LOGA) + (size_t)m0 * 256 + h * 64);
    { const int s = s_, d8 = d8_; float x[8] = {lo_bf(rk.x), hi_bf(rk.x), lo_bf(rk.y), hi_bf(rk.y), lo_bf(rk.z), hi_bf(rk.z), lo_bf(rk.w), hi_bf(rk.w)};
#pragma unroll
      for (int j = 0; j < 8; ++j) x[j] *= __expf(bt[63 * 65 + d8 + j] - bt[s * 65 + d8 + j]);
      u32x4 o; o.x = pk2(x[0], x[1]); o.y = pk2(x[2], x[3]); o.z = pk2(x[4], x[5]); o.w = pk2(x[6], x[7]); *(LAS u32x4*)(kd + s * 72 + d8) = o;
#pragma unroll
      for (int q = 0; q < 2; ++q) { const int ch = (tid & 7) + 8 * q; *(LAS u32x4*)(vt + s * 136 + ch * 8) = rv[q]; } }
    if (tid < 64) WSP(float, WS_DEC)[(size_t)item * 64 + tid] = __expf(bt[63 * 65 + tid]);
    __syncthreads();
    const int mt = w & 3, nh = w >> 2, gq = lane >> 4, ic = lane & 15; float* U = WSP(float, WS_UG) + (size_t)item * 64 * 128;
#pragma unroll
    for (int q = 0; q < 4; ++q) { const int nt = nh * 4 + q; f32x4 acc = (f32x4){0.f, 0.f, 0.f, 0.f};
#pragma unroll
        for (int ks = 0; ks < 2; ++ks) acc = MFMA16(frag_tr(kd, 72, 32 * ks, 16 * mt, lane), frag_tr(vt, 136, 32 * ks, 16 * nt, lane), acc);
#pragma unroll
        for (int r = 0; r < 4; ++r) U[(16 * mt + 4 * gq + r) * 128 + 16 * nt + ic] = acc[r]; }
}
__device__ __forceinline__ void gla_scan(const Frame& F) {
    const int gt = F.bid * NTHREADS + F.tid, NGT = F.G * NTHREADS;
    const float* U = WSP(float, WS_UG), *dec = WSP(float, WS_DEC); bf16_t* S = WSP(bf16_t, WS_SG);
    for (int idx = gt; idx < 16 * 8192; idx += NGT) { const int bh = idx >> 13, e = idx & 8191, d = e >> 7; float s = 0.f;
        float uu[32], dd[32];
#pragma unroll
        for (int j = 0; j < 32; ++j) { const size_t it = (size_t)bh * 32 + j; uu[j] = U[it * 8192 + e]; dd[j] = dec[it * 64 + d]; }
#pragma unroll
        for (int j = 0; j < 32; ++j) { const size_t it = (size_t)bh * 32 + j; S[it * 8192 + e] = (bf16_t)f2bf(s); s = s * dd[j] + uu[j]; } }
}
__device__ __forceinline__ void gla_pass2(const Frame& F, int l, int item) {
    const int bh = item >> 5, c = item & 31, b = bh >> 2, h = bh & 3, m0 = b * SEQ + c * 64, tid = F.tid, lane = F.lane, w = F.wave;
    LAS float* bt = (LAS float*)F.lds; LAS float* seg = (LAS float*)(F.lds + 16896);
    LAS bf16_t* qt = (LAS bf16_t*)(F.lds + 19456); LAS bf16_t* kd = qt + 64 * 72; LAS bf16_t* att = kd + 64 * 72;
    LAS bf16_t* vt = att + 64 * 72; LAS bf16_t* st = vt + 64 * 136; LAS float* ot = (LAS float*)(st + 64 * 136);
    const bf16_t* Z = WSP(bf16_t, WS_Z);
    __syncthreads();
    const int s_ = tid >> 3, d8_ = (tid & 7) * 8; const bf16_t* Sg = WSP(bf16_t, WS_SG) + (size_t)item * 8192;
    const u32x4 rq = __builtin_nontemporal_load((const u32x4*)(Z + (size_t)(m0 + s_) * ZLD + Z_GQ + h * 64 + d8_)), rk = __builtin_nontemporal_load((const u32x4*)(Z + (size_t)(m0 + s_) * ZLD + Z_GK + h * 64 + d8_));
    u32x4 rv[2], rs[2], rog[2];
#pragma unroll
    for (int q = 0; q < 2; ++q) { const int ch = (tid & 7) + 8 * q; rv[q] = __builtin_nontemporal_load((const u32x4*)(Z + (size_t)(m0 + s_) * ZLD + Z_GV + h * 128 + ch * 8)); rs[q] = __builtin_nontemporal_load((const u32x4*)(Sg + s_ * 128 + ch * 8));
        rog[q] = __builtin_nontemporal_load((const u32x4*)(Z + (size_t)(m0 + s_) * ZLD + Z_GO + h * 128 + (tid & 7) * 16 + 8 * q)); }
    gla_cumsum(F, bt, seg, WSP(float, WS_LOGA) + (size_t)m0 * 256 + h * 64);
    { const int s = s_, d8 = d8_; float x[8] = {lo_bf(rq.x), hi_bf(rq.x), lo_bf(rq.y), hi_bf(rq.y), lo_bf(rq.z), hi_bf(rq.z), lo_bf(rq.w), hi_bf(rq.w)};
      float y[8] = {lo_bf(rk.x), hi_bf(rk.x), lo_bf(rk.y), hi_bf(rk.y), lo_bf(rk.z), hi_bf(rk.z), lo_bf(rk.w), hi_bf(rk.w)};
#pragma unroll
      for (int j = 0; j < 8; ++j) { const float bb = bt[s * 65 + d8 + j]; x[j] *= 0.125f * __expf(bb); y[j] *= __expf(-bb); }
      u32x4 o; o.x = pk2(x[0], x[1]); o.y = pk2(x[2], x[3]); o.z = pk2(x[4], x[5]); o.w = pk2(x[6], x[7]); *(LAS u32x4*)(qt + s * 72 + d8) = o;
      o.x = pk2(y[0], y[1]); o.y = pk2(y[2], y[3]); o.z = pk2(y[4], y[5]); o.w = pk2(y[6], y[7]); *(LAS u32x4*)(kd + s * 72 + d8) = o;
#pragma unroll
      for (int q = 0; q < 2; ++q) { const int ch = (tid & 7) + 8 * q; *(LAS u32x4*)(vt + s * 136 + ch * 8) = rv[q]; *(LAS u32x4*)(st + s * 136 + ch * 8) = rs[q]; } }
    __syncthreads();
    const int mt = w & 3, nh = w >> 2, gq = lane >> 4, ic = lane & 15;
#pragma unroll
    for (int q = 0; q < 2; ++q) { const int nt = nh * 2 + q; f32x4 acc = (f32x4){0.f, 0.f, 0.f, 0.f};
        if (nt <= mt) {
#pragma unroll
            for (int ks = 0; ks < 2; ++ks) acc = MFMA16(frag_rm(qt, 72, 16 * mt, 32 * ks, lane), frag_rm(kd, 72, 16 * nt, 32 * ks, lane), acc); }
#pragma unroll
        for (int r = 0; r < 4; ++r) { const int t = 16 * mt + 4 * gq + r, s = 16 * nt + ic; att[t * 72 + s] = (bf16_t)f2bf(s <= t ? acc[r] : 0.f); } }
    __syncthreads();
#pragma unroll
    for (int q = 0; q < 4; ++q) { const int nt = nh * 4 + q; f32x4 acc = (f32x4){0.f, 0.f, 0.f, 0.f};
#pragma unroll
        for (int ks = 0; ks < 2; ++ks) { acc = MFMA16(frag_rm(att, 72, 16 * mt, 32 * ks, lane), frag_tr(vt, 136, 32 * ks, 16 * nt, lane), acc);
            acc = MFMA16(frag_rm(qt, 72, 16 * mt, 32 * ks, lane), frag_tr(st, 136, 32 * ks, 16 * nt, lane), acc); }
#pragma unroll
        for (int r = 0; r < 4; ++r) ot[(16 * mt + 4 * gq + r) * 132 + 16 * nt + ic] = acc[r]; }
    __syncthreads();
    { const int t = tid >> 3, j0 = (tid & 7) * 16; float o[16]; float ss = 0.f;
#pragma unroll
      for (int j = 0; j < 16; ++j) { o[j] = ot[t * 132 + j0 + j]; ss += o[j] * o[j]; }
      ss += shx(ss, 1, lane); ss += shx(ss, 2, lane); ss += shx(ss, 4, lane);
      const float rstd = 1.f / sqrtf(ss * (1.f / 128.f) + LN_EPS); const float* ng = INF(16) + l * 128 + j0;
      float og[16];
#pragma unroll
      for (int q = 0; q < 2; ++q) { og[8 * q + 0] = lo_bf(rog[q].x); og[8 * q + 1] = hi_bf(rog[q].x); og[8 * q + 2] = lo_bf(rog[q].y); og[8 * q + 3] = hi_bf(rog[q].y); og[8 * q + 4] = lo_bf(rog[q].z); og[8 * q + 5] = hi_bf(rog[q].z); og[8 * q + 6] = lo_bf(rog[q].w); og[8 * q + 7] = hi_bf(rog[q].w); }
#pragma unroll
      for (int j = 0; j < 16; ++j) o[j] = o[j] * rstd * ng[j] * siluf_(og[j]);
      unsigned char* yo = WSP(unsigned char, WS_YC8) + (size_t)(m0 + t) * DM + 1024 + h * 128 + j0; st8_fp8(yo, o); st8_fp8(yo + 8, o + 8); }
}

__device__ __forceinline__ float wave_incl_scan_add(float v, int lane) {
#pragma unroll
    for (int o = 1; o < 64; o <<= 1) { const float t = shi(v, lane >= o ? lane - o : lane); if (lane >= o) v += t; }
    return v;
}
__device__ __forceinline__ float wave_incl_scan_max(float v, int lane) {
#pragma unroll
    for (int o = 1; o < 64; o <<= 1) { const float t = shi(v, lane >= o ? lane - o : lane); if (lane >= o) v = fmaxf(v, t); }
    return v;
}
__device__ __forceinline__ void ml_load_vext(const Frame& F, LAS bf16_t* ve, const bf16_t* vsrc  ) {
    const int tid = F.tid, s = tid >> 3;
#pragma unroll
    for (int q = 0; q < 2; ++q) { const int ch = (tid & 7) + 8 * q; *(LAS u32x4*)(ve + s * 152 + ch * 8) = *(const u32x4*)(vsrc + (size_t)s * ZLD + ch * 8); }
    if ((tid & 7) < 3) { u32x4 o = (u32x4){0u, 0u, 0u, 0u}; if ((tid & 7) == 0) o.x = 0x3F80u; *(LAS u32x4*)(ve + s * 152 + 128 + (tid & 7) * 8) = o; }
}
__device__ __forceinline__ void ml_pass1(const Frame& F, int item) {
    const int bh = item >> 5, c = item & 31, b = bh >> 2, h = bh & 3, m0 = b * SEQ + c * 64, tid = F.tid, lane = F.lane, w = F.wave;
    LAS float* wg = (LAS float*)F.lds;
    LAS bf16_t* kw = (LAS bf16_t*)(F.lds + 1024); LAS bf16_t* ve = kw + 64 * 72;
    const float* gif = WSP(float, WS_GIF);
    __syncthreads();
    const u32x4 rmk = *(const u32x4*)(WSP(bf16_t, WS_MK) + (size_t)(m0 + (tid >> 3)) * 256 + h * 64 + (tid & 7) * 8);
    if (w == 0) { const float f = gif[(size_t)(m0 + lane) * 8 + 4 + h], ig = gif[(size_t)(m0 + lane) * 8 + h];
        const float bc = wave_incl_scan_add(f, lane), bl = shi(bc, 63), lw = bl + ig - bc, ml = wave_max(lw, lane);
        wg[lane] = __expf(lw - ml);
        if (lane == 0) { float* sc = WSP(float, WS_MSC) + (size_t)item * 4; sc[0] = ml; sc[1] = bl; } }
    ml_load_vext(F, ve, WSP(bf16_t, WS_Z) + (size_t)m0 * ZLD + Z_MV + h * 128);
    __syncthreads();
    { const int s = tid >> 3, d8 = (tid & 7) * 8; float x[8]; unpack8(rmk, x); const float ww = wg[s];
#pragma unroll
      for (int j = 0; j < 8; ++j) x[j] *= ww;
      u32x4 o; o.x = pk2(x[0], x[1]); o.y = pk2(x[2], x[3]); o.z = pk2(x[4], x[5]); o.w = pk2(x[6], x[7]); *(LAS u32x4*)(kw + s * 72 + d8) = o; }
    __syncthreads();
    const int mt = w & 3, nh = w >> 2, gq = lane >> 4, ic = lane & 15; float* U = WSP(float, WS_UM) + (size_t)item * 64 * 144;
    const int nt0 = nh ? 5 : 0, nt1 = nh ? 9 : 5;
    for (int nt = nt0; nt < nt1; ++nt) { f32x4 acc = (f32x4){0.f, 0.f, 0.f, 0.f};
#pragma unroll
        for (int ks = 0; ks < 2; ++ks) acc = MFMA16(frag_tr(kw, 72, 32 * ks, 16 * mt, lane), frag_tr(ve, 152, 32 * ks, 16 * nt, lane), acc);
#pragma unroll
        for (int r = 0; r < 4; ++r) U[(16 * mt + 4 * gq + r) * 144 + 16 * nt + ic] = acc[r]; }
}
__device__ __forceinline__ void ml_scan(const Frame& F) {
    const int gt = F.bid * NTHREADS + F.tid, NGT = F.G * NTHREADS;
    const float* U = WSP(float, WS_UM); float* sc = WSP(float, WS_MSC); bf16_t* C = WSP(bf16_t, WS_CG);
    for (int idx = gt; idx < 16 * 9216; idx += NGT) { const int bh = idx / 9216, e = idx % 9216; float cv = 0.f, mm = 0.f;
        float uu[32], ml[32], fc[32];
#pragma unroll
        for (int j = 0; j < 32; ++j) { const size_t it = (size_t)bh * 32 + j; uu[j] = U[it * 9216 + e]; ml[j] = sc[it * 4 + 0]; fc[j] = sc[it * 4 + 1]; }
#pragma unroll
        for (int j = 0; j < 32; ++j) { const size_t it = (size_t)bh * 32 + j;
            C[it * 9216 + e] = (bf16_t)f2bf(cv); if (e == 0) sc[it * 4 + 2] = mm;
            const float mn = fmaxf(fc[j] + mm, ml[j]); cv = __expf(fc[j] + mm - mn) * cv + __expf(ml[j] - mn) * uu[j]; mm = mn; } }
}
__device__ __forceinline__ void ml_pass2(const Frame& F, int l, int item) {
    const int bh = item >> 5, c = item & 31, b = bh >> 2, h = bh & 3, m0 = b * SEQ + c * 64, tid = F.tid, lane = F.lane, w = F.wave;
    LAS float* av = (LAS float*)F.lds; LAS float* Mv = av + 64; LAS float* wi = Mv + 64; LAS float* cl = wi + 64;
    LAS bf16_t* qt = (LAS bf16_t*)(F.lds + 1024); LAS bf16_t* kt = qt + 64 * 72; LAS bf16_t* sm = kt + 64 * 72;
    LAS bf16_t* ve = sm + 64 * 72; LAS bf16_t* ce = ve + 64 * 152; LAS float* ot = (LAS float*)(ce + 64 * 152);
    const float* gif = WSP(float, WS_GIF);
    __syncthreads();
    u32x4 rog[2];
#pragma unroll
    for (int q = 0; q < 2; ++q) rog[q] = *(const u32x4*)(WSP(bf16_t, WS_Z) + (size_t)(m0 + (tid >> 3)) * ZLD + Z_MO + h * 128 + (tid & 7) * 16 + 8 * q);
    if (w == 0) { const float f = gif[(size_t)(m0 + lane) * 8 + 4 + h], ig = gif[(size_t)(m0 + lane) * 8 + h];
        const float bc = wave_incl_scan_add(f, lane), a = ig - bc, pm = wave_incl_scan_max(a, lane), mp = WSP(float, WS_MSC)[(size_t)item * 4 + 2], M = fmaxf(mp, pm);
        av[lane] = a; Mv[lane] = M; wi[lane] = __expf(mp - M); cl[lane] = __expf(-(bc + M)); }
    ml_load_vext(F, ve, WSP(bf16_t, WS_Z) + (size_t)m0 * ZLD + Z_MV + h * 128);
    { const int s = tid >> 3, d8 = (tid & 7) * 8;
      *(LAS u32x4*)(qt + s * 72 + d8) = *(const u32x4*)(WSP(bf16_t, WS_MQ) + (size_t)(m0 + s) * 256 + h * 64 + d8);
      *(LAS u32x4*)(kt + s * 72 + d8) = *(const u32x4*)(WSP(bf16_t, WS_MK) + (size_t)(m0 + s) * 256 + h * 64 + d8);
      const bf16_t* Cg = WSP(bf16_t, WS_CG) + (size_t)item * 9216;
      for (int i = tid; i < 64 * 18; i += NTHREADS) { const int r = i / 18, ch = i % 18; *(LAS u32x4*)(ce + r * 152 + ch * 8) = *(const u32x4*)(Cg + r * 144 + ch * 8); } }
    __syncthreads();
    const int mt = w & 3, nh = w >> 2, gq = lane >> 4, ic = lane & 15;
#pragma unroll
    for (int q = 0; q < 2; ++q) { const int nt = nh * 2 + q; f32x4 acc = (f32x4){0.f, 0.f, 0.f, 0.f};
        if (nt <= mt) {
#pragma unroll
            for (int ks = 0; ks < 2; ++ks) acc = MFMA16(frag_rm(qt, 72, 16 * mt, 32 * ks, lane), frag_rm(kt, 72, 16 * nt, 32 * ks, lane), acc); }
        const int s = 16 * nt + ic; const float as = av[s];
#pragma unroll
        for (int r = 0; r < 4; ++r) { const int t = 16 * mt + 4 * gq + r; sm[t * 72 + s] = (bf16_t)f2bf(s <= t ? acc[r] * __expf(as - Mv[t]) : 0.f); } }
    __syncthreads();
    { const int nt0 = nh ? 5 : 0, nt1 = nh ? 9 : 5;
      for (int nt = nt0; nt < nt1; ++nt) { f32x4 a1 = (f32x4){0.f, 0.f, 0.f, 0.f}, a2 = a1;
#pragma unroll
        for (int ks = 0; ks < 2; ++ks) { a1 = MFMA16(frag_rm(sm, 72, 16 * mt, 32 * ks, lane), frag_tr(ve, 152, 32 * ks, 16 * nt, lane), a1);
            a2 = MFMA16(frag_rm(qt, 72, 16 * mt, 32 * ks, lane), frag_tr(ce, 152, 32 * ks, 16 * nt, lane), a2); }
#pragma unroll
        for (int r = 0; r < 4; ++r) { const int t = 16 * mt + 4 * gq + r; ot[t * 148 + 16 * nt + ic] = a1[r] + wi[t] * a2[r]; } } }
    __syncthreads();
    { const int t = tid >> 3, j0 = (tid & 7) * 16; float o[16]; float ss = 0.f; const float den = ot[t * 148 + 128], dn = 1.0f / fmaxf(fabsf(den), cl[t]);
#pragma unroll
      for (int j = 0; j < 16; ++j) { o[j] = ot[t * 148 + j0 + j] * dn; ss += o[j] * o[j]; }
      ss += shx(ss, 1, lane); ss += shx(ss, 2, lane); ss += shx(ss, 4, lane);
      const float rstd = 1.f / sqrtf(ss * (1.f / 128.f) + LN_EPS); const float* ng = INF(20) + l * 128 + j0; const bf16_t* Z = WSP(bf16_t, WS_Z);
      float og[16]; unpack8(rog[0], og); unpack8(rog[1], og + 8);
#pragma unroll
      for (int j = 0; j < 16; ++j) o[j] = o[j] * rstd * ng[j] * sigmoidf_(og[j]);
      unsigned char* yo = WSP(unsigned char, WS_YC8) + (size_t)(m0 + t) * DM + 1536 + h * 128 + j0; st8_fp8(yo, o); st8_fp8(yo + 8, o + 8); }
}

template <int DQK, bool CAUSAL, int QP, int MT, bool OUT8>
__device__ __forceinline__ void attn_block(const Frame& F, const void* Qv, int qld, size_t qpstride, float qscale, const bf16_t* Kp, int kld, const bf16_t* Kr, int krld, const bf16_t* V, int vld, bf16_t* O, int old_, int q0, int nkt) {
    constexpr int KS = DQK + 8, NKS = DQK / 32, BUFB = 64 * KS * 2 + 64 * 136 * 2;
    const int tid = F.tid, lane = F.lane, w = F.wave, gq = lane >> 4, ic = lane & 15;
    const int qw = q0 + 16 * MT * w;
    bf16x8 qf[MT][NKS];
#pragma unroll
    for (int mt = 0; mt < MT; ++mt) {
        if constexpr (QP == 0) { const bf16_t* Q = (const bf16_t*)Qv;
#pragma unroll
            for (int ks = 0; ks < NKS; ++ks) qf[mt][ks] = *(const bf16x8*)(Q + (size_t)(qw + 16 * mt + ic) * qld + 32 * ks + 8 * gq);
        } else { const bf16_t* Q = (const bf16_t*)Qv;
#pragma unroll
            for (int ks = 0; ks < NKS; ++ks) { float a[8] = {0.f, 0.f, 0.f, 0.f, 0.f, 0.f, 0.f, 0.f};
#pragma unroll
                for (int p = 0; p < QP; ++p) { float t_[8]; unpack8(__builtin_nontemporal_load((const u32x4*)(Q + (size_t)p * qpstride + (size_t)(qw + 16 * mt + ic) * qld + 32 * ks + 8 * gq)), t_);
#pragma unroll
                    for (int e = 0; e < 8; ++e) a[e] += t_[e]; }
                const u32x4 pk = (u32x4){pk2(a[0] * qscale, a[1] * qscale), pk2(a[2] * qscale, a[3] * qscale), pk2(a[4] * qscale, a[5] * qscale), pk2(a[6] * qscale, a[7] * qscale)}; qf[mt][ks] = __builtin_bit_cast(bf16x8, pk); } } }
    f32x4 o[MT][8]; float mcol[MT], lcol[MT];
#pragma unroll
    for (int mt = 0; mt < MT; ++mt) { mcol[mt] = -INFINITY; lcol[mt] = 0.f;
#pragma unroll
        for (int i = 0; i < 8; ++i) o[mt][i] = (f32x4){0.f, 0.f, 0.f, 0.f}; }
    constexpr bool ROPE = (DQK > 128);
    u32x4 kreg[2], rreg, vreg[2];
    const int ok_g = (tid >> 4) * kld + (tid & 15) * 8, ov_g = (tid >> 4) * vld + (tid & 15) * 8, or_g = ROPE ? ((tid >> 3) * krld + (tid & 7) * 8) : 0;
    const int ok_l = (tid >> 4) * KS + (tid & 15) * 8, ov_l = (tid >> 4) * 136 + (tid & 15) * 8, or_l = (tid >> 3) * KS + 128 + (tid & 7) * 8;
#define ATT_LOAD(t) do { const bf16_t* kb_ = Kp + (size_t)((t) * 64) * kld; const bf16_t* vb_ = V + (size_t)((t) * 64) * vld; \
        kreg[0] = *(const u32x4*)(kb_ + ok_g); kreg[1] = *(const u32x4*)(kb_ + 32 * kld + ok_g); vreg[0] = *(const u32x4*)(vb_ + ov_g); vreg[1] = *(const u32x4*)(vb_ + 32 * vld + ov_g); \
        if constexpr (ROPE) rreg = *(const u32x4*)(Kr + (size_t)((t) * 64) * krld + or_g); } while (0)
#define ATT_STORE(buf) do { LAS bf16_t* kt_ = (LAS bf16_t*)(F.lds + (buf) * BUFB); LAS bf16_t* vt_ = kt_ + 64 * KS; \
        *(LAS u32x4*)(kt_ + ok_l) = kreg[0]; *(LAS u32x4*)(kt_ + 32 * KS + ok_l) = kreg[1]; *(LAS u32x4*)(vt_ + ov_l) = vreg[0]; *(LAS u32x4*)(vt_ + 32 * 136 + ov_l) = vreg[1]; \
        if constexpr (ROPE) *(LAS u32x4*)(kt_ + or_l) = rreg; } while (0)
    __syncthreads();
    ATT_LOAD(0); ATT_STORE(0);
    __syncthreads();
    for (int t = 0; t < nkt; ++t) {
        const int key0 = t * 64; const bool more = (t + 1 < nkt);
        if (more) ATT_LOAD(t + 1);
        const LAS bf16_t* kt = (const LAS bf16_t*)(F.lds + (t & 1) * BUFB); const LAS bf16_t* vt = kt + 64 * KS;
        f32x4 st[MT][4];
#pragma unroll
        for (int nt = 0; nt < 4; ++nt) {
#pragma unroll
            for (int mt = 0; mt < MT; ++mt) st[mt][nt] = (f32x4){0.f, 0.f, 0.f, 0.f};
#pragma unroll
            for (int ks = 0; ks < NKS; ++ks) { const bf16x8 kf = frag_rm(kt, KS, 16 * nt, 32 * ks, lane);
#pragma unroll
                for (int mt = 0; mt < MT; ++mt) st[mt][nt] = MFMA16(kf, qf[mt][ks], st[mt][nt]); }
            if (MT > 1) __builtin_amdgcn_sched_barrier(0); }
        bf16x8 pf[MT][2];
#pragma unroll
        for (int mt = 0; mt < MT; ++mt) {
            if (CAUSAL && key0 + 63 > qw + 16 * mt) {
#pragma unroll
                for (int nt = 0; nt < 4; ++nt)
#pragma unroll
                    for (int r = 0; r < 4; ++r) if (key0 + 16 * nt + 4 * gq + r > qw + 16 * mt + ic) st[mt][nt][r] = -INFINITY; }
            float mx = -INFINITY;
#pragma unroll
            for (int nt = 0; nt < 4; ++nt) mx = fmaxf(fmaxf(mx, fmaxf(st[mt][nt][0], st[mt][nt][1])), fmaxf(st[mt][nt][2], st[mt][nt][3]));
            mx = fmaxf(mx, shx(mx, 16, lane)); mx = fmaxf(mx, shx(mx, 32, lane));
            const float mn = (mx > mcol[mt] + 11.54f) ? mx : mcol[mt], al = __builtin_amdgcn_exp2f(mcol[mt] - mn); mcol[mt] = mn; float psum = 0.f;
#pragma unroll
            for (int nt = 0; nt < 4; ++nt)
#pragma unroll
                for (int r = 0; r < 4; ++r) { const float p = __builtin_amdgcn_exp2f(st[mt][nt][r] - mn); st[mt][nt][r] = p; psum += p; }
            lcol[mt] = lcol[mt] * al + psum;
#pragma unroll
            for (int ks = 0; ks < 2; ++ks) { const u32x4 pk = (u32x4){pk2(st[mt][2 * ks][0], st[mt][2 * ks][1]), pk2(st[mt][2 * ks][2], st[mt][2 * ks][3]), pk2(st[mt][2 * ks + 1][0], st[mt][2 * ks + 1][1]), pk2(st[mt][2 * ks + 1][2], st[mt][2 * ks + 1][3])};
                pf[mt][ks] = __builtin_bit_cast(bf16x8, pk); }
            if (__builtin_amdgcn_ballot_w64(al != 1.0f)) {
                float ar[4];
#pragma unroll
                for (int r = 0; r < 4; ++r) ar[r] = shi(al, 4 * gq + r);
#pragma unroll
                for (int i = 0; i < 8; ++i) { o[mt][i][0] *= ar[0]; o[mt][i][1] *= ar[1]; o[mt][i][2] *= ar[2]; o[mt][i][3] *= ar[3]; } }
        }
#pragma unroll
        for (int ks = 0; ks < 2; ++ks) { const LAS bf16_t* vp = vt + (32 * ks + 4 * gq + (ic >> 2)) * 136 + 4 * (ic & 3);
#pragma unroll
            for (int nv = 0; nv < 8; ++nv) {
                const s16x4 a = __builtin_bit_cast(s16x4, __builtin_amdgcn_ds_read_tr16_b64_v4i16((LAS s16x4*)(vp + 16 * nv)));
                const s16x4 b = __builtin_bit_cast(s16x4, __builtin_amdgcn_ds_read_tr16_b64_v4i16((LAS s16x4*)(vp + 16 * nv + 16 * 136)));
                const bf16x8 vf = (bf16x8){a[0], a[1], a[2], a[3], b[0], b[1], b[2], b[3]};
#pragma unroll
                for (int mt = 0; mt < MT; ++mt) o[mt][nv] = MFMA16(pf[mt][ks], vf, o[mt][nv]);
                if (MT > 1 && (nv & 1)) __builtin_amdgcn_sched_barrier(0); } }
        if (more) ATT_STORE((t + 1) & 1);
        __syncthreads();
    }
#undef ATT_LOAD
#undef ATT_STORE
    LAS bf16_t* ost = (LAS bf16_t*)(F.lds + w * (16 * 136 * 2));
#pragma unroll
    for (int mt = 0; mt < MT; ++mt) {
        float lsum = lcol[mt]; lsum += shx(lsum, 16, lane); lsum += shx(lsum, 32, lane);
        const float linv = 1.0f / lsum;
#pragma unroll
        for (int r = 0; r < 4; ++r) { const float inv = shi(linv, 4 * gq + r);
#pragma unroll
            for (int nv = 0; nv < 8; ++nv) ost[(4 * gq + r) * 136 + 16 * nv + ic] = (bf16_t)f2bf(o[mt][nv][r] * inv); }
        asm volatile("s_waitcnt lgkmcnt(0)" ::: "memory"); __builtin_amdgcn_wave_barrier();
#pragma unroll
        for (int j = 0; j < 4; ++j) { const int rr = lane >> 2, ch = (lane & 3) + 4 * j; const u32x4 ow = *(const LAS u32x4*)(ost + rr * 136 + ch * 8);
            if constexpr (OUT8) { float f_[8]; unpack8(ow, f_); st8_fp8((unsigned char*)O + (size_t)(qw + 16 * mt + rr) * old_ + ch * 8, f_); }
            else *(u32x4*)(O + (size_t)(qw + 16 * mt + rr) * old_ + ch * 8) = ow; }
        asm volatile("s_waitcnt lgkmcnt(0)" ::: "memory"); __builtin_amdgcn_wave_barrier();
    }
}

struct Args { const void* in[37]; float* out; unsigned char* ws; int ph, layer; };
__device__ __forceinline__ Frame mk_frame(LAS unsigned char* lds_in, int wave_in) {
    Frame F; int wv = wave_in, bid = blockIdx.x; unsigned la = (unsigned)(uintptr_t)lds_in;
    asm volatile("" : "+s"(wv)); asm volatile("" : "+s"(bid)); asm volatile("" : "+s"(la));
    LAS unsigned char* lds = (LAS unsigned char*)(uintptr_t)la;
    const int ln = lane_id();
    unsigned char* ws = (unsigned char*)ldp(lds, 38);
    F.lds = lds; F.tid = wv * 64 + ln; F.lane = ln; F.wave = wv; F.G = gridDim.x; F.bid = bid;
    F.ws = ws; F.out = (float*)ldp(lds, 37); F.ctl = (gu32*)(ws + WS_CTL);
    return F;
}
__device__ __forceinline__ void ptr_table_init(const Args& args, LAS unsigned char* lds) {
    if (threadIdx.x < 39) { const int k = threadIdx.x; const void* p = (k < 37) ? args.in[k] : (k == 37 ? (const void*)args.out : (const void*)args.ws);
        *(LAS unsigned long long*)(lds + PTR_OFF + 8 * k) = (unsigned long long)p; }
    __syncthreads();
}
#define NEWF() const Frame F = mk_frame(lds, wave0)
constexpr int NPH = 18;
template <int PH>
__device__ __forceinline__ void run_phase(LAS unsigned char* lds, int wave0, int l) {
    using namespace pg8;
    if constexpr (PH == 0) { }
    else if constexpr (PH == 1) {
        { NEWF(); StaticOrder S; S.init(WSP(unsigned char, WS_HB8), DM / 2, WSW(unsigned char, WS_WG8, l), DM / 2, NT, 8192, F.G, F.bid);
          EpiGate E{WSP(unsigned char, WS_GQ)}; gemm_phase(F.lds, F.tid, DM / 2, DM / 2, DM / 2, S, E); }
        { NEWF(); StaticOrder S; S.init(WSP(unsigned char, WS_HB8), DM / 2, WSW(unsigned char, WS_WIN, l), DM / 2, NT, 19 * 256, F.G, F.bid); S.skip_from = 16; S.skip_by = 32;
          EpiInProjT<true> E{WSP(bf16_t, WS_Z)}; gemm_phase(F.lds, F.tid, DM / 2, DM / 2, DM / 2, S, E); }
        { NEWF(); StaticOrder S2; S2.init(WSP(unsigned char, WS_MEMB), DM / 2, WSW(unsigned char, WS_WXKV, l), DM / 2, NMEM, 1024, F.G, (F.bid + F.G - 96) % F.G);
          EpiBf16T<true> E2{WSP(bf16_t, WS_XKV), 1024, 1.0f / 64.0f}; gemm_phase(F.lds, F.tid, DM / 2, DM / 2, DM / 2, S2, E2); }
        if (l + 1 < DEPTH && (int)blockIdx.x >= 112) { NEWF(); phase_convert(F, l + 1, 1, (F.bid - 112) * NWAVES + F.wave, (F.G - 112) * NWAVES); }
    }
    else if constexpr (PH == 2) { NEWF(); phase_tokprep(F, l); }
    else if constexpr (PH == 3) {
        { NEWF(); StaticOrder S; S.init(WSP(bf16_t, WS_CQN), 384, WSW(bf16_t, WS_WUQ, l), 384, NT, 768, F.G, F.bid);
          EpiQ E{WSP(bf16_t, WS_Q), WSP(f32x2, WS_CS), 0.07216878364870322f * LOG2E}; gemm_phase(F.lds, F.tid, 384, 384, 384, S, E); }
        { NEWF(); StaticOrder S; S.init(WSP(bf16_t, WS_CKVN), 256, WSW(bf16_t, WS_WUKV, l), 256, NT, 1024, F.G, (F.bid + F.G - 96) % F.G);
          EpiKV E{WSP(bf16_t, WS_KN), WSP(bf16_t, WS_V)}; gemm_phase(F.lds, F.tid, 256, 256, 256, S, E); }
        { NEWF(); for (int it = F.bid; it < 256; it += F.G) sg_item(F, l, it); }
        { NEWF(); for (int it = F.bid; it < 512; it += F.G) gla_pass1(F, it); }
        { NEWF(); for (int it = F.bid; it < 512; it += F.G) ml_pass1(F, it); }
    }
    else if constexpr (PH == 4) { NEWF(); gla_scan(F); ml_scan(F); }
    else if constexpr (PH == 5) {
        { NEWF();
          for (int u = F.bid; u < 256; u += F.G) { const int qb = 15 - (u >> 4), bh = u & 15, b = bh >> 2, h = bh & 3; const size_t r0 = (size_t)b * SEQ;
              attn_block<192, true, 0, 1, true>(F, WSP(bf16_t, WS_Q) + r0 * 768 + h * 192, 768, 0, 1.f, WSP(bf16_t, WS_KN) + r0 * 512 + h * 128, 512, WSP(bf16_t, WS_KR) + r0 * 64, 64,
                                          WSP(bf16_t, WS_V) + r0 * 512 + h * 128, 512, (bf16_t*)(WSP(unsigned char, WS_YC8) + r0 * DM + 512 + h * 128), DM, qb * 128, 2 * (qb + 1)); } }
        { NEWF(); LAS int* qi = (LAS int*)(F.lds + MOE_TAB_OFF); unsigned* qc = (unsigned*)(F.ctl + CW_Q5 + 64 * l);
          if (F.tid == 0) qi[0] = (int)atomicAdd(qc, 1u);
          for (int cur = 0;; cur ^= 1) { __syncthreads(); const int it = qi[cur]; if (it >= 1024) break;
              if (F.tid == 0) qi[cur ^ 1] = (int)atomicAdd(qc, 1u);
              if (it < 512) gla_pass2(F, l, it); else ml_pass2(F, l, it - 512); } }
    }
    else if constexpr (PH == 6) {
        NEWF(); BranchOrder S; S.S0.init(WSP(unsigned char, WS_YC8), DM / 2, WSW(unsigned char, WS_WBR, l), DM / 2, NT, DM, F.G, F.bid); S.A = S.S0.A; S.B = S.S0.B; S.ks = 512;
        EpiBranch8 E{WSP(unsigned char, WS_MRG), WSP(unsigned char, WS_GQ)}; gemm_phase(F.lds, F.tid, DM / 2, DM / 2, 256, S, E);
    }
    else if constexpr (PH == 7) {
        NEWF(); StaticOrder S; S.init(WSP(unsigned char, WS_MRG), DM / 2, WSW(unsigned char, WS_WOUT, l), DM / 2, NT, DM, F.G, F.bid);
        EpiResidLNT<true> E{WSP(bf16_t, WS_HB), INF(23) + l * DM, INF(24) + l * DM, WSP(unsigned long long, WS_LNX) + (size_t)l * 32 * 256 * 8, (unsigned*)(F.ctl + CW_LN1 + 64 * 32 * l), F.lds, WSP(unsigned char, WS_HB8)};
        gemm_phase(F.lds, F.tid, DM / 2, DM / 2, DM / 2, S, E);
    }
    else if constexpr (PH == 8) { NEWF(); ln_rows<1, false, false>(F, nullptr, INF(23) + l * DM, INF(24) + l * DM, l); }
    else if constexpr (PH == 9) {
        NEWF(); SplitKOrder S; S.init(WSP(unsigned char, WS_HB8), DM / 2, WSW(unsigned char, WS_WXQ, l), DM / 2, NT, 512, 256, 4, F.G, F.bid);
        EpiBf16P E{WSP(bf16_t, WS_XQP), 512, (size_t)NT * 512}; gemm_phase(F.lds, F.tid, DM / 2, DM / 2, 256, S, E);
    }
    else if constexpr (PH == 10) {
        NEWF();
        for (int u = F.bid; u < 256; u += F.G) { const int bh = u >> 4, qb = u & 15, b = bh >> 2, h = bh & 3;
            attn_block<128, false, 4, 1, true>(F, WSP(bf16_t, WS_XQP) + (size_t)b * SEQ * 512 + h * 128, 512, (size_t)NT * 512, 0.08838834764831845f * LOG2E, WSP(bf16_t, WS_XKV) + (size_t)b * MEMLEN * 1024 + h * 128, 1024, nullptr, 0,
                                      WSP(bf16_t, WS_XKV) + (size_t)b * MEMLEN * 1024 + 512 + h * 128, 1024, (bf16_t*)(WSP(unsigned char, WS_XO) + (size_t)b * SEQ * 512 + h * 128), 512, qb * 128, 4); }
    }
    else if constexpr (PH == 11) {
        NEWF(); StaticOrder S; S.init(WSP(unsigned char, WS_XO), 256, WSW(unsigned char, WS_WXO, l), 256, NT, DM, F.G, F.bid);
        EpiResidLNT<true> E{WSP(bf16_t, WS_HB), INF(28) + l * DM, INF(29) + l * DM, WSP(unsigned long long, WS_LNX) + (size_t)(4 + l) * 32 * 256 * 8, (unsigned*)(F.ctl + CW_LN1 + 64 * 32 * (4 + l)), F.lds, WSP(unsigned char, WS_HB8)};
        gemm_phase(F.lds, F.tid, 256, 256, 256, S, E);
    }
    else if constexpr (PH == 12) { NEWF(); phase_router(F, l); }
    else if constexpr (PH == 13) { }
    else if constexpr (PH == 14) { }
    else if constexpr (PH == 15) {
        NEWF(); LAS int* off = (LAS int*)(F.lds + MOE_TAB_OFF); LAS int* rt2e = off + 32; LAS int* rowtok = (LAS int*)(F.lds + ROWTAB_OFF); LAS float* roww = (LAS float*)(rowtok + 512);
        moe_offsets(F, l, off, rt2e);
        const int nrt = off[16] >> 8;
        { const int rt0 = (F.bid < nrt * 4) ? F.bid / 4 : -1, rt1 = (F.bid + F.G < nrt * 4) ? (F.bid + F.G) / 4 : -1;
          for (int i = F.tid; i < 512; i += NTHREADS) { rowtok[i] = 0; roww[i] = 0.f; }
          __syncthreads();
          const int* tk = WSP(int, WS_TOK);
          for (int m = F.tid; m < NT; m += NTHREADS) { const int e0 = tk[m * 8 + 0], e1 = tk[m * 8 + 1], r0 = off[e0] + tk[m * 8 + 2], r1 = off[e1] + tk[m * 8 + 3];
              if ((r0 >> 8) == rt0) { rowtok[r0 & 255] = m; roww[r0 & 255] = __int_as_float(tk[m * 8 + 6]); }
              if ((r0 >> 8) == rt1) { rowtok[256 + (r0 & 255)] = m; roww[256 + (r0 & 255)] = __int_as_float(tk[m * 8 + 6]); }
              if ((r1 >> 8) == rt0) { rowtok[r1 & 255] = m; roww[r1 & 255] = __int_as_float(tk[m * 8 + 7]); }
              if ((r1 >> 8) == rt1) { rowtok[256 + (r1 & 255)] = m; roww[256 + (r1 & 255)] = __int_as_float(tk[m * 8 + 7]); } }
          __syncthreads(); }
        MoeGatherOrder S{F.G, F.bid, 4, nrt, (const char*)WSP(unsigned char, WS_HB8), (const char*)WSW(unsigned char, WS_WGU, l), (size_t)256 * DM, (size_t)1024 * DM, rt2e, rowtok, (unsigned)DM};
        EpiGU E{WSP(unsigned char, WS_HID), roww}; gemm_phase(F.lds, F.tid, DM / 2, DM / 2, DM / 2, S, E);
        { const int extra = nrt * 4 - F.G, first = extra > 0 ? (extra < F.G - 32 ? extra : F.G - 32) : 0;
          if (l + 1 < DEPTH && (int)blockIdx.x >= first) { NEWF(); phase_convert(F, l + 1, 2, (F.bid - first) * NWAVES + F.wave, (F.G - first) * NWAVES); } }
    }
    else if constexpr (PH == 16) {
        NEWF(); LAS int* off = (LAS int*)(F.lds + MOE_TAB_OFF); LAS int* rt2e = off + 32;
        moe_offsets(F, l, off, rt2e);
        MoeOrder S{F.G, F.bid, 8, off[16] >> 8, (const char*)WSP(unsigned char, WS_HID), (const char*)WSW(unsigned char, WS_WD, l), (size_t)256 * 512, (size_t)256 * 512, (size_t)DM * 512, rt2e};
        EpiFp8T E{WSP(unsigned char, WS_YD), DM, 16.0f / 64.0f}; gemm_phase(F.lds, F.tid, 256, 256, 256, S, E);
        { const int units = (off[16] >> 8) * 8, rem = units % F.G, first = (rem > 0 && rem < F.G - 32) ? rem : 0;
          if (l + 1 < DEPTH && (int)blockIdx.x >= first) { NEWF(); phase_convert(F, l + 1, 4, (F.bid - first) * NWAVES + F.wave, (F.G - first) * NWAVES); } }
    }
    else if constexpr (PH == 17) { NEWF(); if (l == DEPTH - 1) ln_rows<2, false, true>(F, nullptr, INF(35) + l * DM, INF(36) + l * DM, l); else ln_rows<2, false, false>(F, nullptr, INF(35) + l * DM, INF(36) + l * DM, l); }
}

#if !MK_MULTI
__global__ void __launch_bounds__(NTHREADS, 2) mega_fwd(Args args) {
    extern __shared__ __attribute__((aligned(16))) unsigned char lds_raw[];
    LAS unsigned char* lds = (LAS unsigned char*)lds_raw;
    const int wave0 = __builtin_amdgcn_readfirstlane((int)(threadIdx.x >> 6));
    volatile LAS unsigned* MISC = (volatile LAS unsigned*)(lds + MISC_OFF);
    for (int u = threadIdx.x; u < (LDS_BYTES - RING_BYTES) / 4; u += NTHREADS) ((LAS unsigned*)(lds + RING_BYTES))[u] = 0u;
    __syncthreads();
    ptr_table_init(args, lds);
    const unsigned bar_x = xcd_barrier_post((unsigned*)(args.ws + WS_CTL) + CW_BAR, MISC + 8).x;
#define GB() do { XcdBarrier b_; b_.bar = (unsigned*)((unsigned char*)ldp(lds, 38) + WS_CTL) + CW_BAR; unsigned xx_ = bar_x; asm volatile("" : "+s"(xx_)); b_.x = xx_; b_.st = MISC + 8; \
    xcd_barrier(b_, wave0 * 64 + lane_id()); } while (0)
    { NEWF(); phase_p0(F); } GB();
#pragma unroll 1
    for (int l = 0; l < DEPTH; ++l) {
#define RUNP(k) do { run_phase<k>(lds, wave0, l); GB(); if ((REP_MASK >> k) & 1u) { run_phase<k>(lds, wave0, l); GB(); } } while (0)
        RUNP(1); RUNP(2); RUNP(3); RUNP(4); RUNP(5); RUNP(6); RUNP(7); RUNP(9); RUNP(10); RUNP(11); RUNP(12); RUNP(15); RUNP(16); RUNP(17);
    }
}
#else
template <int PH> __global__ void __launch_bounds__(NTHREADS, 2) k_phase(Args args) {
    extern __shared__ __attribute__((aligned(16))) unsigned char lds_raw[];
    LAS unsigned char* lds = (LAS unsigned char*)lds_raw;
    const int wave0 = __builtin_amdgcn_readfirstlane((int)(threadIdx.x >> 6));
    ptr_table_init(args, lds);
    if constexpr (PH < 0) { NEWF(); phase_p0(F); } else run_phase<PH>(lds, wave0, args.layer);
}
template <int PH> static void launch_ph(const Args& a, hipStream_t st) {
    static bool init = false; if (!init) { (void)hipFuncSetAttribute((const void*)k_phase<PH>, hipFuncAttributeMaxDynamicSharedMemorySize, LDS_BYTES); init = true; }
    k_phase<PH><<<256, NTHREADS, LDS_BYTES, st>>>(a);
}
#endif

extern "C" void kernel_launch(void* const* d_in, const int* in_sizes, int n_in, void* d_out, int out_size, void* d_ws, size_t ws_size, hipStream_t stream) {
    if (n_in != 37 || out_size != NT * DM || ws_size < WS_END) { fprintf(stderr, "kernel_launch: unexpected problem (n_in %d out %d ws %zu need %zu)\n", n_in, out_size, ws_size, (size_t)WS_END); return; }
    (void)hipMemsetAsync((char*)d_ws + WS_CTL, 0, CTL_ZERO_BYTES, stream);
    Args a{};
    for (int i = 0; i < 37; ++i) a.in[i] = d_in[i];
    a.out = (float*)d_out; a.ws = (unsigned char*)d_ws; a.ph = 0; a.layer = 0;
#if !MK_MULTI
    static int grid = 0;
    if (grid == 0) {
        int dev = 0, cus = 0;
        (void)hipGetDevice(&dev); (void)hipDeviceGetAttribute(&cus, hipDeviceAttributeMultiprocessorCount, dev);
        if (hipFuncSetAttribute((const void*)mega_fwd, hipFuncAttributeMaxDynamicSharedMemorySize, LDS_BYTES) != hipSuccess) { fprintf(stderr, "hipFuncSetAttribute failed\n"); grid = -1; return; }
        int per_cu = 0; (void)hipOccupancyMaxActiveBlocksPerMultiprocessor(&per_cu, (const void*)mega_fwd, NTHREADS, LDS_BYTES); (void)hipGetLastError();
        grid = (per_cu >= 1) ? cus : -1;
        if (grid > 256) grid = 256;
    }
    if (grid <= 0) return;
    mega_fwd<<<grid, NTHREADS, LDS_BYTES, stream>>>(a);
#else
    launch_ph<-1>(a, stream);
    for (int l = 0; l < DEPTH; ++l) { a.layer = l;
        launch_ph<0>(a, stream); launch_ph<1>(a, stream); launch_ph<2>(a, stream); launch_ph<3>(a, stream); launch_ph<4>(a, stream); launch_ph<5>(a, stream);
        launch_ph<6>(a, stream); launch_ph<7>(a, stream); launch_ph<8>(a, stream); launch_ph<9>(a, stream); launch_ph<10>(a, stream); launch_ph<11>(a, stream);
        launch_ph<12>(a, stream); launch_ph<13>(a, stream); launch_ph<14>(a, stream); launch_ph<15>(a, stream); launch_ph<16>(a, stream); launch_ph<17>(a, stream); }
#endif
}
```

```cpp
#include <hip/hip_runtime.h>
#include <cstdio>
#include <cstdint>

#ifndef REP_MASK
#define REP_MASK 0u
#endif
#ifndef MK_MULTI
#define MK_MULTI 0
#endif

#define LAS __attribute__((address_space(3)))
#define GAS __attribute__((address_space(1)))
typedef unsigned short bf16_t;
typedef short bf16x8 __attribute__((ext_vector_type(8)));
typedef short s16x4 __attribute__((ext_vector_type(4)));
typedef float f32x4 __attribute__((ext_vector_type(4)));
typedef float f32x2 __attribute__((ext_vector_type(2)));
typedef unsigned u32x4 __attribute__((ext_vector_type(4)));
typedef unsigned u32x2 __attribute__((ext_vector_type(2)));
typedef int v4i_t __attribute__((ext_vector_type(4)));
typedef int v8i_t __attribute__((ext_vector_type(8)));
typedef GAS unsigned gu32;

constexpr int NT = 8192, DM = 2048, SEQ = 2048, NB = 4, DEPTH = 4, MEMLEN = 256, NMEM = NB * MEMLEN;
constexpr int DIN = 13016, ZLD = 13056;
constexpr int Z_SGU = 0, Z_SGV = 512, Z_GQ = 1024, Z_GK = 1280, Z_GV = 1536, Z_GO = 2048, Z_MQK = 2560, Z_MV = 3072, Z_MO = 3584, Z_GATE = 4096,
              Z_CQ = 12288, Z_CKV = 12672, Z_KR = 12928, Z_LR = 12992, Z_IF = 13008;
constexpr float LN_EPS = 1e-5f;
constexpr float ALPHA = 1.681792830507429f;
constexpr float LOG2E = 1.4426950408889634f;
constexpr int XG_ROWS = 20480;
constexpr int NWAVES = 8, NTHREADS = 512;

constexpr size_t MiB = 1u << 20;
constexpr size_t WS_CTL = 0, CTL_ZERO_BYTES = 1 * MiB;
constexpr size_t WS_WIN = 1 * MiB;
constexpr size_t WS_WUQ = WS_WIN + 52 * MiB;
constexpr size_t WS_WUKV = WS_WUQ + 1 * MiB;
constexpr size_t WS_WBR = WS_WUKV + 1 * MiB;
constexpr size_t WS_WOUT = WS_WBR + 8 * MiB;
constexpr size_t WS_WXQ = WS_WOUT + 8 * MiB;
constexpr size_t WS_WXKV = WS_WXQ + 2 * MiB;
constexpr size_t WS_WXO = WS_WXKV + 4 * MiB;
constexpr size_t WS_WGU = WS_WXO + 2 * MiB;
constexpr size_t WS_WD = WS_WGU + 64 * MiB;
constexpr size_t WS_WG8 = WS_WD + 32 * MiB;
constexpr size_t WS_HF = WS_WG8 + 16 * MiB;
constexpr size_t WS_HB = WS_HF + 64 * MiB;
constexpr size_t WS_Z = WS_HB + 32 * MiB;
constexpr size_t WS_VN = WS_Z + 204 * MiB;
constexpr size_t WS_CQN = WS_VN + 8 * MiB;
constexpr size_t WS_CKVN = WS_CQN + 6 * MiB;
constexpr size_t WS_KR = WS_CKVN + 4 * MiB;
constexpr size_t WS_CS = WS_KR + 1 * MiB;
constexpr size_t WS_LOGA = WS_CS + 2 * MiB;
constexpr size_t WS_MQ = WS_LOGA + 8 * MiB;
constexpr size_t WS_MK = WS_MQ + 4 * MiB;
constexpr size_t WS_GIF = WS_MK + 4 * MiB;
constexpr size_t WS_Q = WS_GIF + 1 * MiB;
constexpr size_t WS_KN = WS_Q + 12 * MiB;
constexpr size_t WS_V = WS_KN + 8 * MiB;
constexpr size_t WS_UG = WS_V + 8 * MiB;
constexpr size_t WS_DEC = WS_UG + 16 * MiB;
constexpr size_t WS_SG = WS_DEC + 1 * MiB;
constexpr size_t WS_UM = WS_SG + 8 * MiB;
constexpr size_t WS_CG = WS_UM + 18 * MiB;
constexpr size_t WS_MSC = WS_CG + 9 * MiB;
constexpr size_t WS_YCAT = WS_MSC + 1 * MiB;
constexpr size_t WS_MRG = WS_YCAT + 32 * MiB;
constexpr size_t WS_MEMB = WS_MRG + 32 * MiB;
constexpr size_t WS_XQ = WS_MEMB + 4 * MiB;
constexpr size_t WS_XKV = WS_XQ + 8 * MiB;
constexpr size_t WS_XO = WS_XKV + 2 * MiB;
constexpr size_t WS_TOK = WS_XO + 8 * MiB;
constexpr size_t WS_ROWW = WS_TOK + 1 * MiB;
constexpr size_t WS_XG = WS_ROWW + 1 * MiB;
constexpr size_t WS_HID = WS_XG + 80 * MiB;
constexpr size_t WS_YD = WS_HID + 20 * MiB;
constexpr size_t WS_WRT = WS_YD + 80 * MiB;
constexpr size_t WS_XQP = WS_WRT + 1 * MiB;
constexpr size_t WS_GQ = WS_XQP + 64 * MiB;
constexpr size_t WS_HT = WS_GQ + 64 * MiB;
constexpr size_t WS_LNX = WS_HT + 64 * MiB;
constexpr size_t WS_HB8 = WS_LNX + 4 * MiB;
constexpr size_t WS_YC8 = WS_HB8 + 16 * MiB;
constexpr size_t WS_ENDX = WS_YC8 + 16 * MiB;
constexpr size_t WS_SET1_DELTA = WS_ENDX - WS_WIN;
constexpr size_t WS_END = WS_ENDX + (WS_HF - WS_WIN);

constexpr int CW_BAR = 4096;
constexpr int CW_Q5 = 32768;
constexpr int CW_LN1 = 163840;
constexpr int CW_CNT = 65536;

constexpr int RING_BYTES = 131072;
constexpr int MISC_OFF = RING_BYTES;
constexpr int MOE_TAB_OFF = RING_BYTES + 1024;
constexpr int ROWTAB_OFF = RING_BYTES + 4096;
constexpr int PTR_OFF = RING_BYTES + 2048;
constexpr int LDS_BYTES = 147456;

__device__ __forceinline__ float bf2f(bf16_t x) { return __uint_as_float(((unsigned)x) << 16); }
typedef __bf16 hwbf16x2 __attribute__((ext_vector_type(2)));
__device__ __forceinline__ unsigned pk2(float lo, float hi) { const f32x2 v = {lo, hi}; return __builtin_bit_cast(unsigned, __builtin_convertvector(v, hwbf16x2)); }
__device__ __forceinline__ unsigned f2bf(float f) { return pk2(f, 0.f) & 0xffffu; }
__device__ __forceinline__ float lo_bf(unsigned u) { return __uint_as_float(u << 16); }
__device__ __forceinline__ float hi_bf(unsigned u) { return __uint_as_float(u & 0xffff0000u); }
__device__ __forceinline__ float shx(float v, int o, int lane) { return __int_as_float(__builtin_amdgcn_ds_bpermute((lane ^ o) << 2, __float_as_int(v))); }
__device__ __forceinline__ float shi(float v, int src) { return __int_as_float(__builtin_amdgcn_ds_bpermute(src << 2, __float_as_int(v))); }
__device__ __forceinline__ float wave_sum(float v, int lane) {
#pragma unroll
    for (int o = 1; o < 64; o <<= 1) v += shx(v, o, lane);
    return v;
}
__device__ __forceinline__ float wave_max(float v, int lane) {
#pragma unroll
    for (int o = 1; o < 64; o <<= 1) v = fmaxf(v, shx(v, o, lane));
    return v;
}
__device__ __forceinline__ float sigmoidf_(float x) { return __builtin_amdgcn_rcpf(1.0f + __expf(-x)); }
__device__ __forceinline__ float siluf_(float x) { return x * __builtin_amdgcn_rcpf(1.0f + __expf(-x)); }
__device__ __forceinline__ float logsigmoidf_(float x) { return fminf(x, 0.f) - __logf(1.0f + __expf(-fabsf(x))); }
__device__ __forceinline__ float gelu_tanh(float x) { const float u = 1.5957691216057308f * (x + 0.044715f * x * x * x); return x * __builtin_amdgcn_rcpf(1.0f + __expf(-u)); }
__device__ __forceinline__ int lane_id() { int l; asm volatile("v_mbcnt_lo_u32_b32 %0, -1, 0\n\tv_mbcnt_hi_u32_b32 %0, -1, %0" : "=v"(l)); return l; }
__device__ __forceinline__ void ld8(const bf16_t* p, float* o) { const u32x4 w = *(const u32x4*)p; o[0] = lo_bf(w.x); o[1] = hi_bf(w.x); o[2] = lo_bf(w.y); o[3] = hi_bf(w.y); o[4] = lo_bf(w.z); o[5] = hi_bf(w.z); o[6] = lo_bf(w.w); o[7] = hi_bf(w.w); }
__device__ __forceinline__ void st8(bf16_t* p, const float* o) { u32x4 w; w.x = pk2(o[0], o[1]); w.y = pk2(o[2], o[3]); w.z = pk2(o[4], o[5]); w.w = pk2(o[6], o[7]); *(u32x4*)p = w; }
__device__ __forceinline__ void unpack8(u32x4 w, float* o) { o[0] = lo_bf(w.x); o[1] = hi_bf(w.x); o[2] = lo_bf(w.y); o[3] = hi_bf(w.y); o[4] = lo_bf(w.z); o[5] = hi_bf(w.z); o[6] = lo_bf(w.w); o[7] = hi_bf(w.w); }
__device__ __forceinline__ unsigned pk_fp8x4(float a, float b, float c, float d) { int p = __builtin_amdgcn_cvt_pk_fp8_f32(a, b, 0, false); p = __builtin_amdgcn_cvt_pk_fp8_f32(c, d, p, true); return (unsigned)p; }
__device__ __forceinline__ void st8_fp8(unsigned char* p, const float* o) { u32x2 w; w.x = pk_fp8x4(o[0], o[1], o[2], o[3]); w.y = pk_fp8x4(o[4], o[5], o[6], o[7]); *(u32x2*)p = w; }
__device__ __forceinline__ void unpack8_fp8(unsigned lo, unsigned hi, float* o) { const f32x2 a = __builtin_amdgcn_cvt_pk_f32_fp8((int)lo, false), b = __builtin_amdgcn_cvt_pk_f32_fp8((int)lo, true), c = __builtin_amdgcn_cvt_pk_f32_fp8((int)hi, false), d = __builtin_amdgcn_cvt_pk_f32_fp8((int)hi, true);
    o[0] = a[0]; o[1] = a[1]; o[2] = b[0]; o[3] = b[1]; o[4] = c[0]; o[5] = c[1]; o[6] = d[0]; o[7] = d[1]; }
#define LDS_WAIT() asm volatile("s_waitcnt lgkmcnt(0)" ::: "memory")
#define VM_WAIT() asm volatile("s_waitcnt vmcnt(0)" ::: "memory")

#define XB_TMO      128
#define XB_XCNT(j)  (256  + 64 * (j))
#define XB_XSUB(j)  (1280 + 64 * (j))
#define XB_XGEN(j)  (2304 + 64 * (j))
#define XB_TOP      3328
#define XB_TOPGEN   3392
#define XCD_BAR_WORDS 3456
#define XB_SPIN_CAP (1u << 18)
__device__ __forceinline__ unsigned xb_ld(unsigned* p)              { return __hip_atomic_load(p, __ATOMIC_RELAXED, __HIP_MEMORY_SCOPE_AGENT); }
__device__ __forceinline__ unsigned xb_add(unsigned* p, unsigned v) { return __hip_atomic_fetch_add(p, v, __ATOMIC_RELAXED, __HIP_MEMORY_SCOPE_AGENT); }
__device__ __forceinline__ unsigned xb_xcc_id() { return (unsigned)__builtin_amdgcn_s_getreg((3 << 11) | 20) & 0xFu; }
#define XB_SPIN(cond, bar) do { unsigned _sp = 0; while (cond) { __builtin_amdgcn_s_sleep(1); \
    if ((++_sp & 255u) == 0u) { if (xb_ld(&(bar)[XB_TMO])) break; if (_sp > XB_SPIN_CAP) { atomicAdd(&(bar)[XB_TMO], 1u); break; } } } } while (0)
struct XcdBarrier { unsigned* bar; unsigned x; volatile LAS unsigned* st; };
__device__ __forceinline__ XcdBarrier xcd_barrier_post(unsigned* bar, volatile LAS unsigned* st) {
    XcdBarrier b; b.bar = bar; b.x = (unsigned)__builtin_amdgcn_readfirstlane((int)xb_xcc_id()); b.st = st;
    if (threadIdx.x == 0) (void)xb_add(&bar[XB_XCNT(b.x)], 1u);
    return b;
}
__device__ __forceinline__ void xcd_barrier_complete(unsigned* bar, unsigned x, unsigned& nloc, unsigned& nx) {
    const unsigned G = gridDim.x * gridDim.y * gridDim.z;
    unsigned sum, cnt, mine, sp = 0u;
    for (;;) {
        sum = 0u; cnt = 0u; mine = 0u;
#pragma unroll
        for (unsigned j = 0; j < 16; ++j) { const unsigned c = xb_ld(&bar[XB_XCNT(j)]); sum += c; cnt += (c > 0u) ? 1u : 0u; mine = (j == x) ? c : mine; }
        if (sum == G) break;
        __builtin_amdgcn_s_sleep(1);
        if ((++sp & 255u) == 0u) { if (xb_ld(&bar[XB_TMO])) break; if (sp > XB_SPIN_CAP) { atomicAdd(&bar[XB_TMO], 1u); break; } }
    }
    nloc = mine > 0u ? mine : 1u; nx = cnt > 0u ? cnt : 1u;
}
__device__ __forceinline__ void xcd_barrier(const XcdBarrier& b, int tid) {
    asm volatile("s_waitcnt vmcnt(0)" ::: "memory");
    __syncthreads();
    if (tid == 0) {
        unsigned* bar = b.bar;
        __builtin_amdgcn_s_waitcnt(0);
        unsigned nloc = b.st[0], nx = b.st[1];
        if (nloc == 0u) { xcd_barrier_complete(bar, b.x, nloc, nx); b.st[0] = nloc; b.st[1] = nx; }
        const unsigned old = xb_add(&bar[XB_XSUB(b.x)], 1u);
        const unsigned gen = old / nloc;
        if (old + 1u == (gen + 1u) * nloc) {
            __builtin_amdgcn_fence(__ATOMIC_RELEASE, "agent");
            asm volatile("s_waitcnt vmcnt(0)" ::: "memory");
            const unsigned og = xb_add(&bar[XB_TOP], 1u);
            const unsigned tg = og / nx;
            if (og + 1u == (tg + 1u) * nx) xb_add(&bar[XB_TOPGEN], 1u);
            else XB_SPIN(xb_ld(&bar[XB_TOPGEN]) == tg, bar);
            __builtin_amdgcn_fence(__ATOMIC_ACQUIRE, "agent");
            xb_add(&bar[XB_XGEN(b.x)], 1u);
            asm volatile("s_waitcnt vmcnt(0)" ::: "memory");
        } else {
            XB_SPIN(xb_ld(&bar[XB_XGEN(b.x)]) == gen, bar);
            __builtin_amdgcn_fence(__ATOMIC_ACQUIRE, "agent");
            asm volatile("s_waitcnt vmcnt(0)" ::: "memory");
        }
    }
    __syncthreads();
}

namespace pg8 {
constexpr int BM = 256, BK = 64, HALF = 128, HTB = HALF * BK * 2, STAGE_BYTES = 8 * HTB, NXCD = 8, WGM = 8;
__host__ __device__ __forceinline__ int lds_byte(int r, int c) { const int st = (r >> 4) * 2 + (c >> 5), rr = r & 15, cc = c & 31, ob = rr * 64 + cc * 2; return st * 1024 + (ob ^ (((ob >> 9) & 1) << 5)); }
__host__ __device__ __forceinline__ void stage_rc(int b, int& R, int& C) { const int st = b / 1024, sb = b % 1024, swz = sb ^ (((sb >> 9) & 1) << 5); R = (st >> 1) * 16 + swz / 64; C = (st & 1) * 32 + (swz % 64) / 2; }
__host__ __device__ __forceinline__ int perm32(int rho) { const int n = rho >> 4, i = rho & 15; return 8 * (i >> 2) + 4 * n + (i & 3); }
struct Unit { int pm, pn; const char* A; const char* B; int aux; };

struct StaticOrder {
    static constexpr bool GATHER = false;
    int nM, nN, nwg, G, c; const char* A; const char* B; size_t tA, tB;
    int skip_from = 1 << 30, skip_by = 0;
    __device__ void init(const void* A_, int lda, const void* B_, int ldb, int M, int N, int G_, int c_) { nM = M / BM; nN = N / BM; nwg = nM * nN; G = G_; c = c_; A = (const char*)A_; B = (const char*)B_; tA = (size_t)BM * lda * 2; tB = (size_t)BM * ldb * 2; }
    __device__ bool next(int i, Unit& u) const {
        const long L = (long)i * G + c; if (L >= nwg) return false;
        int wgid = (int)L; { const int q = nwg / NXCD, r = nwg % NXCD, xcd = wgid % NXCD, off = wgid / NXCD; wgid = (xcd < r ? xcd * (q + 1) : r * (q + 1) + (xcd - r) * q) + off; }
        const int nig = WGM * nN, gid = wgid / nig, fm = gid * WGM, gsz = (nM - fm) < WGM ? (nM - fm) : WGM;
        u.pm = fm + ((wgid % nig) % gsz); u.pn = (wgid % nig) / gsz; if (u.pn >= skip_from) u.pn += skip_by; u.A = A + (size_t)u.pm * tA; u.B = B + (size_t)u.pn * tB; return true;
    }
};

struct SplitKOrder {
    static constexpr bool GATHER = false;
    int nN, nwg, G, c, KSPL; const char* A; const char* B; size_t tA, tB, kb;
    __device__ void init(const void* A_, int lda, const void* B_, int ldb, int M, int N, int Kc, int KSPL_, int G_, int c_) { nN = N / BM; KSPL = KSPL_; nwg = (M / BM) * nN * KSPL; G = G_; c = c_; A = (const char*)A_; B = (const char*)B_; tA = (size_t)BM * lda * 2; tB = (size_t)BM * ldb * 2; kb = (size_t)Kc * 2; }
    __device__ bool next(int i, Unit& u) const {
        const long L = (long)i * G + c; if (L >= nwg) return false;
        const int tile = (int)(L / KSPL), ks = (int)(L % KSPL); u.pm = tile / nN; u.pn = tile % nN; u.aux = ks; u.A = A + (size_t)u.pm * tA + ks * kb; u.B = B + (size_t)u.pn * tB + ks * kb; return true;
    }
};

struct BranchOrder {
    static constexpr bool GATHER = false;
    StaticOrder S0; const char* A; const char* B; size_t ks;
    __device__ bool next(int i, Unit& u) const { if (!S0.next(i >> 2, u)) return false; const int nb = i & 3; u.aux = nb; u.A += (size_t)nb * ks; u.B += (size_t)nb * ks; return true; }
};
template <class E, class = void> struct EpiAccum { static constexpr bool v = false; };
template <class E> struct EpiAccum<E, decltype((void)E::ACCUM)> { static constexpr bool v = E::ACCUM; };

template <class Epi, class Sched>
__device__ __forceinline__ void gemm_phase(LAS unsigned char* lds, int tid, int lda, int ldb, int K, const Sched& S, const Epi& E) {
    const int wid = __builtin_amdgcn_readfirstlane(tid >> 6), lane = tid & 63, wr = wid >> 2, wc = wid & 3, fr = lane & 15, fq = lane >> 4;
    const int nt = K / BK;
    unsigned voffB[2]; int RA[2], CA[2];
#pragma unroll
    for (int i = 0; i < 2; ++i) { int R, C; stage_rc(tid * 16 + i * 8192, R, C); RA[i] = R; CA[i] = C; const int Rb = Epi::PERM ? ((R & ~31) + perm32(R & 31)) : R; voffB[i] = (unsigned)(Rb * ldb + C) * 2u; }
    const size_t kstep = (size_t)(BK * 2);
    const size_t hstepA = (size_t)HALF * lda * 2, hstepB = (size_t)HALF * ldb * 2;
    const unsigned ldsw = (unsigned)wid * 1024u;
    const int aoff = lds_byte(wr * 64 + fr, fq * 8), boff = lds_byte(wc * 32 + fr, fq * 8);
#define PG8_SA(b, h) (((b) * 2 + (h)) * HTB)
#define PG8_SB(b, h) ((4 + (b) * 2 + (h)) * HTB)
#define PG8_STAGE_G(bufoff, gbase, voff, isB) do { _Pragma("unroll") for (int _i = 0; _i < 2; ++_i) \
        __builtin_amdgcn_raw_ptr_buffer_load_lds((isB) ? rsB : rsA, (LAS void*)(lds + (bufoff) + ldsw + _i * 8192), 16, (int)(voff)[_i], (int)(unsigned)((const char*)(gbase) - ((isB) ? S.B : S.A)), 0, 0); } while (0)
#define PG8_STAGE(bufoff, gbase, voff) PG8_STAGE_G(bufoff, gbase, voff, 1)
#define PG8_STAGE_A(bufoff, gbase, h, o0, o1) do { if constexpr (Sched::GATHER) { if (h) PG8_STAGE_G(bufoff, gbase, o1, 0); else PG8_STAGE_G(bufoff, gbase, o0, 0); } else PG8_STAGE_G(bufoff, (gbase) + (h) * hstepA, o0, 0); } while (0)
#define PG8_LD8(dst, p0, p1) do { (dst).lo = *(const LAS v4i_t*)(p0); (dst).hi = *(const LAS v4i_t*)(p1); } while (0)
#define PG8_LDA(dst, b, h) do { if constexpr (Epi::FP8) { _Pragma("unroll") for (int m = 0; m < 4; ++m) PG8_LD8(dst##8[m], lds + PG8_SA(b, h) + aoff + m * 2048, lds + PG8_SA(b, h) + aoff + m * 2048 + 1024); } \
    else { _Pragma("unroll") for (int m = 0; m < 4; ++m) _Pragma("unroll") for (int k = 0; k < 2; ++k) dst[m][k] = *(const LAS bf16x8*)(lds + PG8_SA(b, h) + aoff + m * 2048 + k * 1024); } } while (0)
#define PG8_LDB(dst, b, h) do { if constexpr (Epi::FP8) { _Pragma("unroll") for (int n = 0; n < 2; ++n) PG8_LD8(dst##8[n], lds + PG8_SB(b, h) + boff + n * 2048, lds + PG8_SB(b, h) + boff + n * 2048 + 1024); } \
    else { _Pragma("unroll") for (int n = 0; n < 2; ++n) _Pragma("unroll") for (int k = 0; k < 2; ++k) dst[n][k] = *(const LAS bf16x8*)(lds + PG8_SB(b, h) + boff + n * 2048 + k * 1024); } } while (0)
#define PG8_MMA(ai, bj, At, Bt) do { if constexpr (Epi::FP8) { PG8_MMA8(ai, bj, At, Bt); } else { __builtin_amdgcn_s_setprio(1); _Pragma("unroll") for (int m = 0; m < 4; ++m) _Pragma("unroll") for (int n = 0; n < 2; ++n) _Pragma("unroll") for (int k = 0; k < 2; ++k) \
        acc[ai][bj][m][n] = __builtin_amdgcn_mfma_f32_16x16x32_bf16(Bt[n][k], At[m][k], acc[ai][bj][m][n], 0, 0, 0); __builtin_amdgcn_s_setprio(0); } } while (0)
#define PG8_MMA8(ai, bj, At, Bt) do { __builtin_amdgcn_s_setprio(1); _Pragma("unroll") for (int m = 0; m < 4; ++m) _Pragma("unroll") for (int n = 0; n < 2; ++n) \
        acc[ai][bj][m][n] = __builtin_amdgcn_mfma_scale_f32_16x16x128_f8f6f4(Bt##8[n], At##8[m], acc[ai][bj][m][n], 0, 0, 0, 0x7F7F7F7F, 0, 0x7F7F7F7F); __builtin_amdgcn_s_setprio(0); } while (0)
#define PG8_WAIT_V(n) asm volatile("s_waitcnt vmcnt(" #n ")" ::: "memory")
#define PG8_WAIT_L(n) asm volatile("s_waitcnt lgkmcnt(" #n ")" ::: "memory")
#define PG8_BAR __builtin_amdgcn_s_barrier()
#define PG8_SCHED __builtin_amdgcn_sched_barrier(0)
    Unit cur, nxt; int ui = 0;
    if (!S.next(0, cur)) return;
    const __amdgpu_buffer_rsrc_t rsA = __builtin_amdgcn_make_buffer_rsrc((void*)S.A, 0, 0x7fffffff, 0x00020000), rsB = __builtin_amdgcn_make_buffer_rsrc((void*)S.B, 0, 0x7fffffff, 0x00020000);
    f32x4 acc[2][2][4][2];
    { float zz; asm volatile("v_mov_b32 %0, 0" : "=v"(zz));
#pragma unroll
    for (int a = 0; a < 2; ++a)
#pragma unroll
        for (int b = 0; b < 2; ++b)
#pragma unroll
            for (int m = 0; m < 4; ++m)
#pragma unroll
                for (int n = 0; n < 2; ++n) acc[a][b][m][n] = (f32x4){zz, zz, zz, zz}; }
    bf16x8 At[4][2], B0[2][2], B1[2][2]; v8i_t At8[4], B08[2], B18[2];
    const char* cA = cur.A; const char* cB = cur.B;
    unsigned vA0[2], vA1[2];
#define PG8_AOFFS(d0, d1, un) do { _Pragma("unroll") for (int _i = 0; _i < 2; ++_i) { if constexpr (Sched::GATHER) { d0[_i] = S.row_off(un, RA[_i]) + (unsigned)CA[_i] * 2u; d1[_i] = S.row_off(un, HALF + RA[_i]) + (unsigned)CA[_i] * 2u; } \
        else { d0[_i] = (unsigned)(RA[_i] * lda + CA[_i]) * 2u; d1[_i] = 0u; } } } while (0)
    PG8_AOFFS(vA0, vA1, cur);
    PG8_STAGE(PG8_SB(0, 0), cB, voffB); PG8_STAGE(PG8_SB(0, 1), cB + hstepB, voffB); PG8_STAGE_A(PG8_SA(0, 0), cA, 0, vA0, vA1); PG8_STAGE_A(PG8_SA(0, 1), cA, 1, vA0, vA1);
    if (wr == 1) PG8_BAR;
    PG8_WAIT_V(2); PG8_BAR;
    PG8_STAGE(PG8_SB(1, 0), cB + kstep, voffB); PG8_STAGE_A(PG8_SA(1, 0), cA + kstep, 0, vA0, vA1); PG8_STAGE(PG8_SB(1, 1), cB + hstepB + kstep, voffB);
    PG8_WAIT_V(6); PG8_BAR;
    for (;;) {
        const bool has_next = S.next(ui + 1, nxt);
        const char* nA = has_next ? nxt.A : cA; const char* nB = has_next ? nxt.B : cB;
#pragma unroll 1
        for (int t = 0; t < nt; t += 2) {
            const bool last = (t == nt - 2);
            const char* a1 = cA + (size_t)(t + 1) * kstep;
            const char* a2 = last ? nA : cA + (size_t)(t + 2) * kstep; const char* b2 = last ? nB : cB + (size_t)(t + 2) * kstep;
            const char* a3 = a2 + kstep; const char* b3 = b2 + kstep;
            PG8_LDB(B0, 0, 0); PG8_LDB(B1, 0, 1); PG8_SCHED; PG8_LDA(At, 0, 0); PG8_STAGE_A(PG8_SA(1, 1), a1, 1, vA0, vA1);
            PG8_WAIT_V(8); PG8_WAIT_L(0); PG8_BAR; PG8_MMA(0, 0, At, B0); PG8_MMA(0, 1, At, B1); PG8_BAR; PG8_SCHED;
            if constexpr (Sched::GATHER) { if (last && has_next) PG8_AOFFS(vA0, vA1, nxt); }
            PG8_LDA(At, 0, 1); PG8_STAGE(PG8_SB(0, 0), b2, voffB); PG8_STAGE(PG8_SB(0, 1), b2 + hstepB, voffB); PG8_STAGE_A(PG8_SA(0, 0), a2, 0, vA0, vA1);
            PG8_WAIT_V(8); PG8_WAIT_L(0); PG8_BAR; PG8_MMA(1, 0, At, B0); PG8_MMA(1, 1, At, B1); PG8_BAR; PG8_SCHED;
            PG8_LDB(B0, 1, 0); PG8_LDB(B1, 1, 1); PG8_SCHED; PG8_LDA(At, 1, 0); PG8_STAGE_A(PG8_SA(0, 1), a2, 1, vA0, vA1);
            PG8_WAIT_V(8); PG8_WAIT_L(0); PG8_BAR; PG8_MMA(0, 0, At, B0); PG8_MMA(0, 1, At, B1); PG8_BAR; PG8_SCHED;
            PG8_LDA(At, 1, 1); PG8_STAGE(PG8_SB(1, 0), b3, voffB); PG8_STAGE(PG8_SB(1, 1), b3 + hstepB, voffB); PG8_STAGE_A(PG8_SA(1, 0), a3, 0, vA0, vA1);
            PG8_WAIT_V(8); PG8_WAIT_L(0); PG8_BAR; PG8_MMA(1, 0, At, B0); PG8_MMA(1, 1, At, B1); PG8_BAR; PG8_SCHED;
            if constexpr (Epi::KHOOK) { constexpr int HP = Epi::FP8 ? 4 : 8; if (!last && ((t + 2) & (HP - 1)) == 0) { const int tz = lane_id(); E.khook(acc, cur, (t + 2) / HP, wr, wc, tz & 15, tz >> 4); } }
        }
        if (wr == 0) PG8_BAR;
        { const int tz = lane_id(); if constexpr (Epi::MUT) E.fused(acc, cur, wr, wc, tz & 15, tz >> 4); else E(acc, cur, wr, wc, tz & 15, tz >> 4); }
        if (!has_next) break;
        bool keep = false; if constexpr (EpiAccum<Epi>::v) keep = cur.aux < 3;
        if (!keep) { float zz; asm volatile("v_mov_b32 %0, 0" : "=v"(zz));
#pragma unroll
        for (int a = 0; a < 2; ++a)
#pragma unroll
            for (int b = 0; b < 2; ++b)
#pragma unroll
                for (int m = 0; m < 4; ++m)
#pragma unroll
                    for (int n = 0; n < 2; ++n) acc[a][b][m][n] = (f32x4){zz, zz, zz, zz}; }
        cur = nxt; cA = nA; cB = nB; ++ui;
        if (wr == 1) PG8_BAR;
    }
    PG8_WAIT_V(0);
    PG8_BAR;
#undef PG8_AOFFS
#undef PG8_LD8
#undef PG8_MMA8
#undef PG8_STAGE_A
#undef PG8_STAGE_G
#undef PG8_SA
#undef PG8_SB
#undef PG8_STAGE
#undef PG8_LDA
#undef PG8_LDB
#undef PG8_MMA
#undef PG8_WAIT_V
#undef PG8_WAIT_L
#undef PG8_BAR
#undef PG8_SCHED
}
}

#define EPI_LOOP_BEGIN _Pragma("unroll") for (int ai = 0; ai < 2; ++ai) _Pragma("unroll") for (int m = 0; m < 4; ++m) { const int row = u.pm * 256 + ai * 128 + wr * 64 + m * 16 + fr; \
    _Pragma("unroll") for (int bj = 0; bj < 2; ++bj) _Pragma("unroll") for (int n = 0; n < 2; ++n) { const int col = u.pn * 256 + bj * 128 + wc * 32 + n * 16 + 4 * fq; f32x4 v = acc[ai][bj][m][n];
#define EPI_LOOP_END } }
#define EPI8_LOOP_BEGIN _Pragma("unroll") for (int ai = 0; ai < 2; ++ai) _Pragma("unroll") for (int m = 0; m < 4; ++m) { const int row = u.pm * 256 + ai * 128 + wr * 64 + m * 16 + fr; \
    _Pragma("unroll") for (int bj = 0; bj < 2; ++bj) { const int col = u.pn * 256 + bj * 128 + wc * 32 + 8 * fq; f32x4 v0 = acc[ai][bj][m][0], v1 = acc[ai][bj][m][1];
#define EPI8_LOOP_END } }
typedef f32x4 AccT[2][2][4][2];

__device__ __forceinline__ void st_bf16x8(bf16_t* p, f32x4 a, f32x4 b) { u32x4 w; w.x = pk2(a[0], a[1]); w.y = pk2(a[2], a[3]); w.z = pk2(b[0], b[1]); w.w = pk2(b[2], b[3]); *(u32x4*)p = w; }
__device__ __forceinline__ void st_bf16x4(bf16_t* p, f32x4 v) { u32x2 w; w.x = pk2(v[0], v[1]); w.y = pk2(v[2], v[3]); *(u32x2*)p = w; }

struct EpiGate { static constexpr bool KHOOK = false, PERM = true, MUT = false, FP8 = true; unsigned char* GQ;
    __device__ __forceinline__ void operator()(const AccT& acc, const pg8::Unit& u, int wr, int wc, int fr, int fq) const {
        const int tid = (wr * 4 + wc) * 64 + fq * 16 + fr; u32x4* gp = (u32x4*)GQ + ((size_t)(u.pm * 32 + u.pn) * 8) * 512 + tid;
#pragma unroll
        for (int ai = 0; ai < 2; ++ai)
#pragma unroll
            for (int m = 0; m < 4; ++m) { u32x4 o = (u32x4){0u, 0u, 0u, 0u};
#pragma unroll
                for (int bj = 0; bj < 2; ++bj)
#pragma unroll
                    for (int n = 0; n < 2; ++n) { const f32x4 t = acc[ai][bj][m][n] * (-LOG2E / 64.0f); f32x4 e; unsigned wv = 0;
#pragma unroll
                        for (int j = 0; j < 4; ++j) e[j] = __builtin_amdgcn_exp2f(t[j]);
                        const f32x4 d = e * (1.0f / 256.0f) + (1.0f / 256.0f); f32x4 r;
#pragma unroll
                        for (int j = 0; j < 4; ++j) r[j] = __builtin_amdgcn_rcpf(d[j]);
                        const f32x4 q = r - 0.5f;
#pragma unroll
                        for (int j = 0; j < 4; ++j) wv = __builtin_amdgcn_cvt_pk_u8_f32(q[j], (unsigned)j, wv);
                        o[bj * 2 + n] = wv; }
                __builtin_nontemporal_store(o, gp + (size_t)(ai * 4 + m) * 512); }
    }
};
template <bool F8> struct EpiInProjT { static constexpr bool KHOOK = false, PERM = true, MUT = false, FP8 = F8; bf16_t* Z;
    __device__ __forceinline__ void operator()(const AccT& acc, const pg8::Unit& u, int wr, int wc, int fr, int fq) const {
        const int mode = (u.pn < 4) ? 1 : 0; const float sc = F8 ? (1.0f / 64.0f) : 1.0f;
        EPI8_LOOP_BEGIN
            v0 *= sc; v1 *= sc;
            if (mode == 1) {
#pragma unroll
                for (int j = 0; j < 4; ++j) { v0[j] = gelu_tanh(v0[j]); v1[j] = gelu_tanh(v1[j]); } }
            st_bf16x8(Z + (size_t)row * ZLD + col, v0, v1);
        EPI8_LOOP_END
    }
};
template <bool F8> struct EpiBf16T { static constexpr bool KHOOK = false, PERM = true, MUT = false, FP8 = F8; bf16_t* O; int ldo; float scale;
    __device__ __forceinline__ void operator()(const AccT& acc, const pg8::Unit& u, int wr, int wc, int fr, int fq) const {
        EPI8_LOOP_BEGIN
            st_bf16x8(O + (size_t)row * ldo + col, v0 * scale, v1 * scale);
        EPI8_LOOP_END
    }
};
struct EpiFp8T { static constexpr bool KHOOK = false, PERM = true, MUT = false, FP8 = true; unsigned char* O; int ldo; float scale;
    __device__ __forceinline__ void operator()(const AccT& acc, const pg8::Unit& u, int wr, int wc, int fr, int fq) const {
        EPI8_LOOP_BEGIN
            { u32x2 w_; w_.x = pk_fp8x4(v0[0] * scale, v0[1] * scale, v0[2] * scale, v0[3] * scale); w_.y = pk_fp8x4(v1[0] * scale, v1[1] * scale, v1[2] * scale, v1[3] * scale); *(u32x2*)(O + (size_t)row * ldo + col) = w_; }
        EPI8_LOOP_END
    }
};
struct EpiBf16P { static constexpr bool KHOOK = false, PERM = true, MUT = false, FP8 = true; bf16_t* P; int ldo; size_t slab;
    __device__ __forceinline__ void operator()(const AccT& acc, const pg8::Unit& u, int wr, int wc, int fr, int fq) const {
        EPI8_LOOP_BEGIN
            st_bf16x8(P + (size_t)u.aux * slab + (size_t)row * ldo + col, v0 * (1.0f / 64.0f), v1 * (1.0f / 64.0f));
        EPI8_LOOP_END
    }
};
struct EpiQ { static constexpr bool KHOOK = false, PERM = true, MUT = false, FP8 = false; bf16_t* Q; const f32x2* cs; float scale;
    __device__ __forceinline__ void operator()(const AccT& acc, const pg8::Unit& u, int wr, int wc, int fr, int fq) const {
        EPI8_LOOP_BEGIN
            const int j = col % 192;
            if (j >= 128) { const int i0 = (j - 128) >> 1; const f32x2 c0 = cs[(size_t)row * 32 + i0], c1 = cs[(size_t)row * 32 + i0 + 1], c2 = cs[(size_t)row * 32 + i0 + 2], c3 = cs[(size_t)row * 32 + i0 + 3];
                v0 = (f32x4){v0[0] * c0.x - v0[1] * c0.y, v0[0] * c0.y + v0[1] * c0.x, v0[2] * c1.x - v0[3] * c1.y, v0[2] * c1.y + v0[3] * c1.x};
                v1 = (f32x4){v1[0] * c2.x - v1[1] * c2.y, v1[0] * c2.y + v1[1] * c2.x, v1[2] * c3.x - v1[3] * c3.y, v1[2] * c3.y + v1[3] * c3.x}; }
            st_bf16x8(Q + (size_t)row * 768 + col, v0 * scale, v1 * scale);
        EPI8_LOOP_END
    }
};
struct EpiKV { static constexpr bool KHOOK = false, PERM = true, MUT = false, FP8 = false; bf16_t* KN; bf16_t* V;
    __device__ __forceinline__ void operator()(const AccT& acc, const pg8::Unit& u, int wr, int wc, int fr, int fq) const {
        EPI8_LOOP_BEGIN
            const int h = col >> 8, j = col & 255;
            bf16_t* dst = (j < 128) ? (KN + (size_t)row * 512 + h * 128 + j) : (V + (size_t)row * 512 + h * 128 + (j - 128));
            st_bf16x8(dst, v0, v1);
        EPI8_LOOP_END
    }
};
struct EpiBranch { static constexpr bool KHOOK = true, PERM = true, MUT = false, FP8 = false; unsigned char* O; const unsigned char* GQ;
    __device__ __forceinline__ const u32x4* gptr(const pg8::Unit& u, int nb, int wr, int wc, int fr, int fq) const { const int tid = (wr * 4 + wc) * 64 + fq * 16 + fr; return (const u32x4*)GQ + ((size_t)(u.pm * 32 + nb * 8 + u.pn) * 8) * 512 + tid; }
    __device__ __forceinline__ void khook(AccT& acc, const pg8::Unit& u, int nb, int wr, int wc, int fr, int fq) const {
        const u32x4* g0 = gptr(u, nb - 1, wr, wc, fr, fq); const u32x4* g1 = gptr(u, nb, wr, wc, fr, fq);
        u32x4 a[8], b[8];
#pragma unroll
        for (int c = 0; c < 8; ++c) { a[c] = g0[(size_t)c * 512]; b[c] = g1[(size_t)c * 512]; }
#pragma unroll
        for (int ai = 0; ai < 2; ++ai)
#pragma unroll
            for (int m = 0; m < 4; ++m)
#pragma unroll
                for (int bj = 0; bj < 2; ++bj)
#pragma unroll
                    for (int n = 0; n < 2; ++n) { const unsigned wa = a[ai * 4 + m][bj * 2 + n], wb = b[ai * 4 + m][bj * 2 + n];
#pragma unroll
                        for (int j = 0; j < 4; ++j) { const float ga = (float)((wa >> (8 * j)) & 255u) + 0.5f, gb = (float)((wb >> (8 * j)) & 255u) + 0.5f;
                            acc[ai][bj][m][n][j] *= ga * __builtin_amdgcn_rcpf(gb); } }
    }
    __device__ __forceinline__ void operator()(const AccT& acc, const pg8::Unit& u, int wr, int wc, int fr, int fq) const {
        const u32x4* g3 = gptr(u, 3, wr, wc, fr, fq);
        u32x4 a[8];
#pragma unroll
        for (int c = 0; c < 8; ++c) a[c] = g3[(size_t)c * 512];
        EPI8_LOOP_BEGIN
            const unsigned wa0 = a[ai * 4 + m][bj * 2 + 0], wa1 = a[ai * 4 + m][bj * 2 + 1];
#pragma unroll
            for (int j = 0; j < 4; ++j) { v0[j] *= ((float)((wa0 >> (8 * j)) & 255u) + 0.5f) * (1.0f / 256.0f); v1[j] *= ((float)((wa1 >> (8 * j)) & 255u) + 0.5f) * (1.0f / 256.0f); }
            { u32x2 w_; w_.x = pk_fp8x4(v0[0], v0[1], v0[2], v0[3]); w_.y = pk_fp8x4(v1[0], v1[1], v1[2], v1[3]); *(u32x2*)(O + (size_t)row * DM + col) = w_; }
        EPI8_LOOP_END
    }
};
struct EpiBranch8 { static constexpr bool KHOOK = false, PERM = true, MUT = true, FP8 = true, ACCUM = true; unsigned char* O; const unsigned char* GQ;
    __device__ __forceinline__ const u32x4* gptr(const pg8::Unit& u, int nb, int wr, int wc, int fr, int fq) const { const int tid = (wr * 4 + wc) * 64 + fq * 16 + fr; return (const u32x4*)GQ + ((size_t)(u.pm * 32 + nb * 8 + u.pn) * 8) * 512 + tid; }
    __device__ __forceinline__ void fused(AccT& acc, const pg8::Unit& u, int wr, int wc, int fr, int fq) const {
        if (u.aux < 3) {
            const u32x4* g0 = gptr(u, u.aux, wr, wc, fr, fq); const u32x4* g1 = gptr(u, u.aux + 1, wr, wc, fr, fq);
            u32x4 a[8], b[8];
#pragma unroll
            for (int c = 0; c < 8; ++c) { a[c] = __builtin_nontemporal_load(g0 + (size_t)c * 512); b[c] = g1[(size_t)c * 512]; }
#pragma unroll
            for (int ai = 0; ai < 2; ++ai)
#pragma unroll
                for (int m = 0; m < 4; ++m)
#pragma unroll
                    for (int bj = 0; bj < 2; ++bj)
#pragma unroll
                        for (int n = 0; n < 2; ++n) { const unsigned wa = a[ai * 4 + m][bj * 2 + n], wb = b[ai * 4 + m][bj * 2 + n];
                            f32x4 fa = (f32x4){(float)(wa & 255u), (float)((wa >> 8) & 255u), (float)((wa >> 16) & 255u), (float)(wa >> 24)}, fb = (f32x4){(float)(wb & 255u), (float)((wb >> 8) & 255u), (float)((wb >> 16) & 255u), (float)(wb >> 24)}, r;
                            fa += 0.5f; fb += 0.5f;
#pragma unroll
                            for (int j = 0; j < 4; ++j) r[j] = __builtin_amdgcn_rcpf(fb[j]);
                            acc[ai][bj][m][n] *= fa * r; }
        } else {
            const u32x4* g3 = gptr(u, 3, wr, wc, fr, fq);
            u32x4 a[8];
#pragma unroll
            for (int c = 0; c < 8; ++c) a[c] = __builtin_nontemporal_load(g3 + (size_t)c * 512);
            EPI8_LOOP_BEGIN
                const unsigned wa0 = a[ai * 4 + m][bj * 2 + 0], wa1 = a[ai * 4 + m][bj * 2 + 1];
#pragma unroll
                for (int j = 0; j < 4; ++j) { v0[j] *= ((float)((wa0 >> (8 * j)) & 255u) + 0.5f) * (1.0f / (256.0f * 64.0f)); v1[j] *= ((float)((wa1 >> (8 * j)) & 255u) + 0.5f) * (1.0f / (256.0f * 64.0f)); }
                { u32x2 w_; w_.x = pk_fp8x4(v0[0], v0[1], v0[2], v0[3]); w_.y = pk_fp8x4(v1[0], v1[1], v1[2], v1[3]); *(u32x2*)(O + (size_t)row * DM + col) = w_; }
            EPI8_LOOP_END
        }
    }
};
struct EpiResid { static constexpr bool KHOOK = false, PERM = true, MUT = false, FP8 = false; const bf16_t* H; bf16_t* T;
    __device__ __forceinline__ void operator()(const AccT& acc, const pg8::Unit& u, int wr, int wc, int fr, int fq) const {
        EPI8_LOOP_BEGIN
            float h[8]; ld8(H + (size_t)row * DM + col, h);
#pragma unroll
            for (int j = 0; j < 4; ++j) { v0[j] += ALPHA * h[j]; v1[j] += ALPHA * h[4 + j]; }
            st_bf16x8(T + (size_t)row * DM + col, v0, v1);
        EPI8_LOOP_END
    }
};
template <bool F8> struct EpiResidLNT { static constexpr bool KHOOK = false, PERM = true, MUT = true, FP8 = F8;
    bf16_t* H; const float* g; const float* b; unsigned long long* xs; unsigned* cnt; LAS unsigned char* lds; unsigned char* H8;
    __device__ __forceinline__ void fused(AccT& acc, const pg8::Unit& u, int wr, int wc, int fr, int fq) const {
        LAS f32x2* P = (LAS f32x2*)(lds + ROWTAB_OFF); LAS f32x2* S = (LAS f32x2*)(lds + ROWTAB_OFF + 8192);
        const int lane = fq * 16 + fr, tid = (wr * 4 + wc) * 64 + lane;
#pragma unroll
        for (int ai = 0; ai < 2; ++ai)
#pragma unroll
            for (int m = 0; m < 4; ++m) { const int rl = ai * 128 + wr * 64 + m * 16 + fr; const size_t row = (size_t)u.pm * 256 + rl; float s1 = 0.f, s2 = 0.f;
#pragma unroll
                for (int bj = 0; bj < 2; ++bj) { const int col = u.pn * 256 + bj * 128 + wc * 32 + 8 * fq; float h[8]; unpack8(__builtin_nontemporal_load((const u32x4*)(H + row * DM + col)), h);
#pragma unroll
                    for (int j = 0; j < 4; ++j) { const float asc = F8 ? (1.0f / 64.0f) : 1.0f; const float x0 = acc[ai][bj][m][0][j] * asc + ALPHA * h[j], x1 = acc[ai][bj][m][1][j] * asc + ALPHA * h[4 + j];
                        acc[ai][bj][m][0][j] = x0; acc[ai][bj][m][1][j] = x1; s1 += x0 + x1; s2 += x0 * x0 + x1 * x1; } }
                s1 += shx(s1, 16, lane); s1 += shx(s1, 32, lane); s2 += shx(s2, 16, lane); s2 += shx(s2, 32, lane);
                if (fq == 0) P[rl * 4 + wc] = (f32x2){s1, s2}; }
        asm volatile("s_waitcnt lgkmcnt(0)" ::: "memory"); __builtin_amdgcn_s_barrier(); asm volatile("" ::: "memory");
        unsigned long long* slot = xs + ((size_t)u.pm * 256) * 8;
        if (tid < 256) { const f32x2 a0 = P[tid * 4 + 0], a1 = P[tid * 4 + 1], a2 = P[tid * 4 + 2], a3 = P[tid * 4 + 3]; const float t1 = (a0.x + a1.x) + (a2.x + a3.x), t2 = (a0.y + a1.y) + (a2.y + a3.y);
            __hip_atomic_store(slot + (size_t)tid * 8 + u.pn, ((unsigned long long)__float_as_uint(t2) << 32) | __float_as_uint(t1), __ATOMIC_RELAXED, __HIP_MEMORY_SCOPE_AGENT); }
        asm volatile("s_waitcnt vmcnt(0)" ::: "memory"); __builtin_amdgcn_s_barrier(); asm volatile("" ::: "memory");
        if (tid == 0) { unsigned* c = cnt + 64 * u.pm; __hip_atomic_fetch_add(c, 1u, __ATOMIC_RELAXED, __HIP_MEMORY_SCOPE_AGENT); unsigned sp = 0;
            while (__hip_atomic_load(c, __ATOMIC_RELAXED, __HIP_MEMORY_SCOPE_AGENT) < 8u && ++sp < (1u << 21)) __builtin_amdgcn_s_sleep(1); }
        asm volatile("" ::: "memory"); __builtin_amdgcn_s_barrier(); asm volatile("" ::: "memory");
        if (tid < 256) { float t1 = 0.f, t2 = 0.f;
#pragma unroll
            for (int t = 0; t < 8; ++t) { const unsigned long long v = __hip_atomic_load(slot + (size_t)tid * 8 + t, __ATOMIC_RELAXED, __HIP_MEMORY_SCOPE_AGENT); t1 += __uint_as_float((unsigned)v); t2 += __uint_as_float((unsigned)(v >> 32)); }
            const float mean = t1 * (1.f / DM), var = fmaxf(t2 * (1.f / DM) - mean * mean, 0.f); S[tid] = (f32x2){mean, __builtin_amdgcn_rsqf(var + LN_EPS)}; }
        asm volatile("s_waitcnt lgkmcnt(0)" ::: "memory"); __builtin_amdgcn_s_barrier(); asm volatile("" ::: "memory");
        f32x4 gq[2][2], bq[2][2];
#pragma unroll
        for (int bj = 0; bj < 2; ++bj) { const int col = u.pn * 256 + bj * 128 + wc * 32 + 8 * fq; gq[bj][0] = *(const f32x4*)(g + col); gq[bj][1] = *(const f32x4*)(g + col + 4); bq[bj][0] = *(const f32x4*)(b + col); bq[bj][1] = *(const f32x4*)(b + col + 4); }
#pragma unroll
        for (int ai = 0; ai < 2; ++ai)
#pragma unroll
            for (int m = 0; m < 4; ++m) { const int rl = ai * 128 + wr * 64 + m * 16 + fr; const size_t row = (size_t)u.pm * 256 + rl; const f32x2 ms = S[rl];
#pragma unroll
                for (int bj = 0; bj < 2; ++bj) { const int col = u.pn * 256 + bj * 128 + wc * 32 + 8 * fq;
                    const f32x4 g0 = gq[bj][0], g1 = gq[bj][1], b0 = bq[bj][0], b1 = bq[bj][1]; f32x4 y0, y1;
#pragma unroll
                    for (int j = 0; j < 4; ++j) { y0[j] = (acc[ai][bj][m][0][j] - ms.x) * ms.y * g0[j] + b0[j]; y1[j] = (acc[ai][bj][m][1][j] - ms.x) * ms.y * g1[j] + b1[j]; }
                    st_bf16x8(H + row * DM + col, y0, y1);
                    if (H8 != nullptr) { u32x2 w8; w8.x = pk_fp8x4(y0[0], y0[1], y0[2], y0[3]); w8.y = pk_fp8x4(y1[0], y1[1], y1[2], y1[3]); *(u32x2*)(H8 + row * DM + col) = w8; } } }
    }
};
struct EpiGU { static constexpr bool KHOOK = false, PERM = true, MUT = false, FP8 = true; unsigned char* HID;
    const LAS float* roww;
    __device__ __forceinline__ void operator()(const AccT& acc, const pg8::Unit& u, int wr, int wc, int fr, int fq) const {
#pragma unroll
        for (int ai = 0; ai < 2; ++ai)
#pragma unroll
            for (int m = 0; m < 4; ++m) { const int lrow = ai * 128 + wr * 64 + m * 16 + fr, row = u.pm * 256 + lrow; const float w = roww[u.aux * 256 + lrow] * (1.0f / 64.0f);
#pragma unroll
                for (int bj = 0; bj < 2; ++bj) { const int f = u.pn * 128 + bj * 64 + wc * 16 + 4 * fq; const f32x4 g = acc[ai][bj][m][0], up = acc[ai][bj][m][1]; f32x4 e, r;
                    const f32x4 t = g * (-LOG2E / 64.0f);
#pragma unroll
                    for (int j = 0; j < 4; ++j) e[j] = __builtin_amdgcn_exp2f(t[j]);
                    const f32x4 d = e + 1.0f;
#pragma unroll
                    for (int j = 0; j < 4; ++j) r[j] = __builtin_amdgcn_rcpf(d[j]);
                    const f32x4 o = (g * up) * (r * (w * (1.0f / 64.0f)));
                    *(unsigned*)(HID + (size_t)row * 512 + f) = pk_fp8x4(o[0], o[1], o[2], o[3]); } }
    }
};

struct MoeOrder {
    static constexpr bool GATHER = false;
    int G, c, NC, nrt; const char* A; const char* B; size_t tA, tB, eB; const LAS int* rt2e;
    __device__ bool next(int i, pg8::Unit& u) const {
        const long L = (long)i * G + c; if (L >= (long)nrt * NC) return false;
        const int rt = (int)(L / NC), ct = (int)(L % NC); u.pm = rt; u.pn = ct; u.aux = i; u.A = A + (size_t)rt * tA; u.B = B + (size_t)rt2e[rt] * eB + (size_t)ct * tB; return true;
    }
};
struct MoeGatherOrder {
    static constexpr bool GATHER = true;
    int G, c, NC, nrt; const char* A; const char* B; size_t tB, eB; const LAS int* rt2e; const LAS int* rowtok; unsigned rowbytes;
    __device__ bool next(int i, pg8::Unit& u) const {
        const long L = (long)i * G + c; if (L >= (long)nrt * NC) return false;
        const int rt = (int)(L / NC), ct = (int)(L % NC); u.pm = rt; u.pn = ct; u.aux = i; u.A = A; u.B = B + (size_t)rt2e[rt] * eB + (size_t)ct * tB; return true;
    }
    __device__ __forceinline__ unsigned row_off(const pg8::Unit& u, int R) const { return (unsigned)rowtok[u.aux * 256 + R] * rowbytes; }
};

struct Frame {
    LAS unsigned char* lds;
    int tid, lane, wave, G, bid;
    unsigned char* ws; float* out;
    gu32* ctl;
};
__device__ __forceinline__ const void* ldp(LAS unsigned char* lds, int k) {
    const u32x2 w = *(const LAS u32x2*)(lds + PTR_OFF + 8 * k);
    const unsigned long long a = ((unsigned long long)(unsigned)__builtin_amdgcn_readfirstlane((int)w.y) << 32) | (unsigned)__builtin_amdgcn_readfirstlane((int)w.x);
    return (const void*)a;
}
#define INF(k) ((const float*)ldp(F.lds, (k)))
#define WSP(T, off) ((T*)(F.ws + (off)))
#define WSW(T, off, l) ((T*)(F.ws + (off) + (size_t)((l) & 1) * WS_SET1_DELTA))

__device__ __forceinline__ bf16x8 frag_rm(const LAS bf16_t* base, int stride, int row0, int k0, int lane) { return *(const LAS bf16x8*)(base + (row0 + (lane & 15)) * stride + k0 + 8 * (lane >> 4)); }
__device__ __forceinline__ bf16x8 frag_tr(const LAS bf16_t* base, int stride, int k0, int n0, int lane) {
    const int g = lane >> 4, i = lane & 15; const LAS bf16_t* p = base + (k0 + 8 * g + (i >> 2)) * stride + n0 + 4 * (i & 3);
    const s16x4 a = __builtin_bit_cast(s16x4, __builtin_amdgcn_ds_read_tr16_b64_v4i16((LAS s16x4*)p));
    const s16x4 b = __builtin_bit_cast(s16x4, __builtin_amdgcn_ds_read_tr16_b64_v4i16((LAS s16x4*)(p + 4 * stride)));
    return (bf16x8){a[0], a[1], a[2], a[3], b[0], b[1], b[2], b[3]};
}
#define MFMA16(a, b, c) __builtin_amdgcn_mfma_f32_16x16x32_bf16((a), (b), (c), 0, 0, 0)

template <class Map>
__device__ __forceinline__ void convert_wT(const Frame& F, const Map& mp, int nmat, int K, int Ndst, bf16_t* dst, size_t dst_mat_stride, int ldd, int koff, int gw, int NGW) {
    LAS float* scr = (LAS float*)(F.lds + F.wave * 9216);
    const int lane = F.lane;
    const int nbk = Ndst / 32, per = (K / 64) * nbk, items = nmat * per;
    for (int it = gw; it < items; it += NGW) {
        const int e = it / per, r = it % per, kb = r / nbk, nb = r % nbk, k0 = 64 * kb, n0 = 32 * nb;
        const float* cp = mp.colptr(e, n0 + (lane & 31)); const int ld = mp.ld;
#pragma unroll 8
        for (int i = 0; i < 32; ++i) { const int kk = 2 * i + (lane >> 5); scr[kk * 33 + (lane & 31)] = cp ? cp[(size_t)(k0 + kk) * ld] : 0.f; }
        LDS_WAIT();
        const int c = lane & 7;
#pragma unroll
        for (int j = 0; j < 4; ++j) { const int n = (lane >> 3) + 8 * j; const LAS float* s = scr + (8 * c) * 33 + n;
            u32x4 o; o.x = pk2(s[0 * 33], s[1 * 33]); o.y = pk2(s[2 * 33], s[3 * 33]); o.z = pk2(s[4 * 33], s[5 * 33]); o.w = pk2(s[6 * 33], s[7 * 33]);
            *(u32x4*)(dst + (size_t)e * dst_mat_stride + (size_t)(n0 + n) * ldd + koff + k0 + 8 * c) = o; }
        LDS_WAIT();
    }
}
template <class Map>
__device__ __forceinline__ void convert_wT4(const Frame& F, const Map& mp, int nmat, int K, int Ndst, bf16_t* dst, size_t dst_mat_stride, int ldd, int koff, int& rot, int gw0, int NGW) {
    LAS bf16_t* tl = (LAS bf16_t*)(F.lds + F.wave * 9216);
    const int lane = F.lane;
    const int nbk = Ndst / 64, per = (K / 64) * nbk, items = nmat * per;
    int gw = (gw0 + NGW - (rot % NGW)) % NGW; rot += items;
    const int c4 = (lane & 15) * 4, r4 = lane >> 4;
#define CV_LOAD(arr, it_) do { const int e_ = (it_) / per, r_ = (it_) % per, k0_ = 64 * (r_ / nbk), n0_ = 64 * (r_ % nbk); const float* cp_ = mp.colptr(e_, n0_ + c4); \
        _Pragma("unroll") for (int i = 0; i < 16; ++i) arr[i] = cp_ ? __builtin_nontemporal_load((const f32x4*)(cp_ + (size_t)(k0_ + 4 * i + r4) * mp.ld)) : (f32x4){0.f, 0.f, 0.f, 0.f}; } while (0)
#define CV_PROC(arr, it_) do { const int e_ = (it_) / per, r_ = (it_) % per, k0_ = 64 * (r_ / nbk), n0_ = 64 * (r_ % nbk); \
        _Pragma("unroll") for (int i = 0; i < 16; ++i) { u32x2 w_; w_.x = pk2(arr[i][0], arr[i][1]); w_.y = pk2(arr[i][2], arr[i][3]); *(LAS u32x2*)(tl + (4 * i + r4) * 72 + c4) = w_; } \
        LDS_WAIT(); \
        bf16_t* db_ = dst + (size_t)e_ * dst_mat_stride + (size_t)(n0_ + (lane & 15)) * ldd + koff + k0_ + 8 * (lane >> 4); \
        _Pragma("unroll") for (int kk = 0; kk < 2; ++kk) _Pragma("unroll") for (int nn = 0; nn < 4; ++nn) { const bf16x8 o_ = frag_tr(tl, 72, 32 * kk, 16 * nn, lane); *(bf16x8*)(db_ + (size_t)(16 * nn) * ldd + 32 * kk) = o_; } \
        LDS_WAIT(); } while (0)
    f32x4 va[16], vb[16], vc[16];
    int it = gw;
    if (it < items) CV_LOAD(va, it);
    if (it + NGW < items) CV_LOAD(vb, it + NGW);
    while (it < items) {
        if (it + 2 * NGW < items) CV_LOAD(vc, it + 2 * NGW);
        CV_PROC(va, it); it += NGW; if (it >= items) break;
        if (it + 2 * NGW < items) CV_LOAD(va, it + 2 * NGW);
        CV_PROC(vb, it); it += NGW; if (it >= items) break;
        if (it + 2 * NGW < items) CV_LOAD(vb, it + 2 * NGW);
        CV_PROC(vc, it); it += NGW;
    }
#undef CV_LOAD
#undef CV_PROC
}
template <class Map>
__device__ __forceinline__ void convert_wT4_fp8(const Frame& F, const Map& mp, int K, int Ndst, unsigned char* dst, int ldd, int& rot, int gw0, int NGW) {
    LAS bf16_t* tl = (LAS bf16_t*)(F.lds + F.wave * 9216);
    const int lane = F.lane;
    const int nbk = Ndst / 64, items = (K / 64) * nbk;
    int gw = (gw0 + NGW - (rot % NGW)) % NGW; rot += items;
    const int c4 = (lane & 15) * 4, r4 = lane >> 4;
    for (int it = gw; it < items; it += NGW) {
        const int k0 = 64 * (it / nbk), n0 = 64 * (it % nbk); const float* cp = mp.colptr(0, n0 + c4);
        f32x4 v[16];
#pragma unroll
        for (int i = 0; i < 16; ++i) v[i] = cp ? __builtin_nontemporal_load((const f32x4*)(cp + (size_t)(k0 + 4 * i + r4) * mp.ld)) : (f32x4){0.f, 0.f, 0.f, 0.f};
#pragma unroll
        for (int i = 0; i < 16; ++i) { u32x2 w_; w_.x = pk2(v[i][0] * 64.f, v[i][1] * 64.f); w_.y = pk2(v[i][2] * 64.f, v[i][3] * 64.f); *(LAS u32x2*)(tl + (4 * i + r4) * 72 + c4) = w_; }
        LDS_WAIT();
        unsigned char* db = dst + (size_t)(n0 + (lane & 15)) * ldd + k0 + 8 * (lane >> 4);
#pragma unroll
        for (int kk = 0; kk < 2; ++kk)
#pragma unroll
            for (int nn = 0; nn < 4; ++nn) { const bf16x8 o = frag_tr(tl, 72, 32 * kk, 16 * nn, lane); const u32x4 ow = __builtin_bit_cast(u32x4, o); float f[8]; unpack8(ow, f);
                st8_fp8(db + (size_t)(16 * nn) * ldd + 32 * kk, f); }
        LDS_WAIT();
    }
}
struct MapIdent { const float* W; int ld; size_t mstride; __device__ const float* colptr(int e, int n) const { return W + (size_t)e * mstride + n; } };
struct MapWin { const float* W; int ld; int noff;
    __device__ const float* colptr(int, int n_) const {
        const int n = n_ + noff; int s;
        if (n < 1024) s = n; else if (n < 2560) s = 1728 + (n - 1024); else if (n < 4096) s = 3280 + (n - 2560); else if (n < 12288) s = 4824 + (n - 4096);
        else if (n < 12992) s = 1024 + (n - 12288); else if (n < 13008) s = 3264 + (n - 12992); else if (n < 13016) s = 4816 + (n - 13008); else return nullptr;
        return W + s; } };
struct MapUq { const float* W; int ld;
    __device__ const float* colptr(int, int n) const { const int h = n / 192, j = n % 192; if (j < 128) return W + n; const int jj = j - 128, i = jj >> 1; return W + h * 192 + 128 + ((jj & 1) ? 32 + i : i); } };
struct MapGU { const float* Wg; const float* Wu; int ld;
    __device__ const float* colptr(int e, int n) const { const int q = n >> 5, i = n & 31; const long long d = (const char*)Wu - (const char*)Wg;
        return (const float*)((const char*)Wg + (((i >> 2) & 1) ? d : 0ll)) + (size_t)e * 2048 * 512 + 16 * q + 4 * (i >> 3) + (i & 3); } };
__device__ __forceinline__ void phase_convert(const Frame& F, int l, int part, int gw, int NGW) {
    int rot = 0;
    if (part & 1) {
        { MapWin mp{INF(5) + (size_t)l * DM * DIN, DIN, 0}; convert_wT4_fp8(F, mp, DM, 4096, WSW(unsigned char, WS_WIN, l), DM, rot, gw, NGW); }
        { MapWin mp{INF(5) + (size_t)l * DM * DIN, DIN, 12288}; convert_wT4_fp8(F, mp, DM, 768, WSW(unsigned char, WS_WIN, l) + (size_t)12288 * DM, DM, rot, gw, NGW); }
        { MapIdent mp{INF(5) + (size_t)l * DM * DIN + 4824, DIN, 0}; convert_wT4_fp8(F, mp, DM, 8192, WSW(unsigned char, WS_WG8, l), DM, rot, gw, NGW); }
    }
    if (part & 4) {
#pragma unroll 1
        for (int e = 0; e < 16; ++e) { MapIdent mp{INF(34) + ((size_t)l * 16 + e) * 512 * DM, DM, 0}; convert_wT4_fp8(F, mp, 512, DM, WSW(unsigned char, WS_WD, l) + (size_t)e * DM * 512, 512, rot, gw, NGW); } }
    if (part & 2) {
#pragma unroll 1
        for (int e = 0; e < 16; ++e) { MapGU mp{INF(32) + ((size_t)l * 16 + e) * DM * 512, INF(33) + ((size_t)l * 16 + e) * DM * 512, 512}; convert_wT4_fp8(F, mp, DM, 1024, WSW(unsigned char, WS_WGU, l) + (size_t)e * 1024 * DM, DM, rot, gw, NGW); }
#pragma unroll 1
        for (int n = 0; n < 4; ++n) { MapIdent mp{INF(21) + ((size_t)l * 4 + n) * 512 * DM, DM, 0}; convert_wT4_fp8(F, mp, 512, DM, WSW(unsigned char, WS_WBR, l) + n * 512, DM, rot, gw, NGW); }
        { MapIdent mp{INF(22) + (size_t)l * DM * DM, DM, 0}; convert_wT4_fp8(F, mp, DM, DM, WSW(unsigned char, WS_WOUT, l), DM, rot, gw, NGW); }
        { MapIdent mp{INF(25) + (size_t)l * DM * 512, 512, 0}; convert_wT4_fp8(F, mp, DM, 512, WSW(unsigned char, WS_WXQ, l), DM, rot, gw, NGW); }
        { MapIdent mp{INF(26) + (size_t)l * DM * 1024, 1024, 0}; convert_wT4_fp8(F, mp, DM, 1024, WSW(unsigned char, WS_WXKV, l), DM, rot, gw, NGW); }
        { MapIdent mp{INF(27) + (size_t)l * 512 * DM, DM, 0}; convert_wT4_fp8(F, mp, 512, DM, WSW(unsigned char, WS_WXO, l), 512, rot, gw, NGW); }
        { MapIdent mp{INF(13) + (size_t)l * 256 * 1024, 1024, 0}; convert_wT4(F, mp, 1, 256, 1024, WSW(bf16_t, WS_WUKV, l), 0, 256, 0, rot, gw, NGW); }
        { MapUq mp{INF(12) + (size_t)l * 384 * 768, 768}; convert_wT(F, mp, 1, 384, 768, WSW(bf16_t, WS_WUQ, l), 0, 384, 0, gw, NGW); }
    }
}

__device__ __forceinline__ void moe_offsets(const Frame& F, int l, LAS int* off  , LAS int* rt2e  ) {
    __syncthreads();
    if (F.tid < 16) off[128 + F.tid] = (int)__hip_atomic_load((const unsigned*)(F.ctl + CW_CNT + 64 * l) + F.tid, __ATOMIC_RELAXED, __HIP_MEMORY_SCOPE_AGENT);
    __syncthreads();
    if (F.tid == 0) { int o = 0;
        for (int e = 0; e < 16; ++e) { off[e] = o; const int n = off[128 + e]; const int nr = (n + 255) >> 8; for (int r = 0; r < nr; ++r) rt2e[(o >> 8) + r] = e; o += nr << 8; }
        off[16] = o; }
    __syncthreads();
}
struct LnRaw { u32x4 a[4], b[4], c[4]; };
template <int MODE>
__device__ __forceinline__ void ln_load(const Frame& F, LnRaw& r, const float* src, int m, int lane, int row0, int row1) {
    if (MODE == 0) {
#pragma unroll
        for (int j = 0; j < 4; ++j) { r.a[j] = *(const u32x4*)(src + (size_t)m * DM + lane * 8 + 512 * j); r.b[j] = *(const u32x4*)(src + (size_t)m * DM + lane * 8 + 512 * j + 4); }
    } else if (MODE == 1) { const bf16_t* hT = WSP(bf16_t, WS_HT);
#pragma unroll
        for (int j = 0; j < 4; ++j) r.a[j] = *(const u32x4*)(hT + (size_t)m * DM + lane * 8 + 512 * j);
    } else { const bf16_t* hB = WSP(bf16_t, WS_HB); const unsigned char* yd = WSP(unsigned char, WS_YD);
#pragma unroll
        for (int j = 0; j < 4; ++j) { r.a[j] = __builtin_nontemporal_load((const u32x4*)(hB + (size_t)m * DM + lane * 8 + 512 * j)); const u32x2 b_ = __builtin_nontemporal_load((const u32x2*)(yd + (size_t)row0 * DM + lane * 8 + 512 * j)), c_ = __builtin_nontemporal_load((const u32x2*)(yd + (size_t)row1 * DM + lane * 8 + 512 * j));
            r.b[j].x = b_.x; r.b[j].y = b_.y; r.c[j].x = c_.x; r.c[j].y = c_.y; }
    }
}
template <int MODE, bool WF32, bool FINAL>
__device__ __forceinline__ void ln_rows(const Frame& F, const float* src, const float* g, const float* b, int l) {
    float* hF = WSP(float, WS_HF); bf16_t* hB = WSP(bf16_t, WS_HB);
    const int gw = F.bid * NWAVES + F.wave, NGW = F.G * NWAVES, lane = F.lane;
    const LAS int* off = (const LAS int*)(F.lds + MOE_TAB_OFF); const int* tkb = WSP(int, WS_TOK);
    if (MODE == 2) { moe_offsets(F, l, (LAS int*)(F.lds + MOE_TAB_OFF), (LAS int*)(F.lds + MOE_TAB_OFF) + 32); }
    int r0n = 0, r1n = 0, r0nn = 0, r1nn = 0;
    if (MODE == 2) { if (gw < NT) { const int* tk = tkb + (size_t)gw * 8; r0n = off[tk[0]] + tk[2]; r1n = off[tk[1]] + tk[3]; } }
    f32x4 gv[4][2], bv[4][2];
#pragma unroll
    for (int j = 0; j < 4; ++j) { const int c0 = lane * 8 + 512 * j; gv[j][0] = *(const f32x4*)(g + c0); gv[j][1] = *(const f32x4*)(g + c0 + 4); bv[j][0] = *(const f32x4*)(b + c0); bv[j][1] = *(const f32x4*)(b + c0 + 4); }
    LnRaw cur, nxt;
    if (gw < NT) ln_load<MODE>(F, cur, src, gw, lane, r0n, r1n);
    if (MODE == 2) { if (gw + NGW < NT) { const int* tk = tkb + (size_t)(gw + NGW) * 8; r0n = off[tk[0]] + tk[2]; r1n = off[tk[1]] + tk[3]; } }
    for (int m = gw; m < NT; m += NGW) {
        const int mn = m + NGW;
        if (mn < NT) ln_load<MODE>(F, nxt, src, mn, lane, r0n, r1n);
        if (MODE == 2) { if (mn + NGW < NT) { const int* tk = tkb + (size_t)(mn + NGW) * 8; r0nn = off[tk[0]] + tk[2]; r1nn = off[tk[1]] + tk[3]; } }
        float v[4][8]; float s = 0.f;
        if (MODE == 0) {
#pragma unroll
            for (int j = 0; j < 4; ++j) { v[j][0] = __uint_as_float(cur.a[j].x); v[j][1] = __uint_as_float(cur.a[j].y); v[j][2] = __uint_as_float(cur.a[j].z); v[j][3] = __uint_as_float(cur.a[j].w);
                v[j][4] = __uint_as_float(cur.b[j].x); v[j][5] = __uint_as_float(cur.b[j].y); v[j][6] = __uint_as_float(cur.b[j].z); v[j][7] = __uint_as_float(cur.b[j].w); }
        } else if (MODE == 1) {
#pragma unroll
            for (int j = 0; j < 4; ++j) unpack8(cur.a[j], v[j]);
        } else {
#pragma unroll
            for (int j = 0; j < 4; ++j) { float a[8], c[8]; unpack8(cur.a[j], v[j]); unpack8_fp8(cur.b[j].x, cur.b[j].y, a); unpack8_fp8(cur.c[j].x, cur.c[j].y, c);
#pragma unroll
                for (int e = 0; e < 8; ++e) v[j][e] = v[j][e] * ALPHA + (a[e] + c[e]) * (1.0f / 16.0f); }
        }
#pragma unroll
        for (int j = 0; j < 4; ++j)
#pragma unroll
            for (int e = 0; e < 8; ++e) s += v[j][e];
        const float mean = wave_sum(s, lane) * (1.f / DM); float s2 = 0.f;
#pragma unroll
        for (int j = 0; j < 4; ++j)
#pragma unroll
            for (int e = 0; e < 8; ++e) { v[j][e] -= mean; s2 += v[j][e] * v[j][e]; }
        const float rstd = __builtin_amdgcn_rsqf(wave_sum(s2, lane) * (1.f / DM) + LN_EPS);
#pragma unroll
        for (int j = 0; j < 4; ++j) { const int c0 = lane * 8 + 512 * j;
            const f32x4 g0 = gv[j][0], g1 = gv[j][1], b0 = bv[j][0], b1 = bv[j][1];
#pragma unroll
            for (int e = 0; e < 4; ++e) { v[j][e] = v[j][e] * rstd * g0[e] + b0[e]; v[j][4 + e] = v[j][4 + e] * rstd * g1[e] + b1[e]; }
            if (!FINAL) { st8(hB + (size_t)m * DM + c0, v[j]); if (MODE != 1) st8_fp8(WSP(unsigned char, WS_HB8) + (size_t)m * DM + c0, v[j]); }
            if (WF32) { *(f32x4*)(hF + (size_t)m * DM + c0) = (f32x4){v[j][0], v[j][1], v[j][2], v[j][3]}; *(f32x4*)(hF + (size_t)m * DM + c0 + 4) = (f32x4){v[j][4], v[j][5], v[j][6], v[j][7]}; }
            if (FINAL) { *(f32x4*)(F.out + (size_t)m * DM + c0) = (f32x4){v[j][0], v[j][1], v[j][2], v[j][3]}; *(f32x4*)(F.out + (size_t)m * DM + c0 + 4) = (f32x4){v[j][4], v[j][5], v[j][6], v[j][7]}; } }
        cur = nxt; r0n = r0nn; r1n = r1nn;
    }
}

__device__ __forceinline__ void phase_ln2_router(const Frame& F, const float* g, const float* b, int l) {
    bf16_t* hB = WSP(bf16_t, WS_HB); const bf16_t* hT = WSP(bf16_t, WS_HT); const bf16_t* wrt = WSP(bf16_t, WS_WRT);
    LAS unsigned char* Hhi = F.lds; LAS unsigned char* Hlo = F.lds + 65536; LAS float* part = (LAS float*)(F.lds + ROWTAB_OFF);
    const int lane = F.lane, w = F.wave, gq = lane >> 4, ic = lane & 15;
    const float* rb = INF(31);
    for (int grp = F.bid; grp < NT / 16; grp += F.G) {
        const int m0 = grp * 16;
        __syncthreads();
        u32x4 raw[2][4];
#pragma unroll
        for (int rr = 0; rr < 2; ++rr)
#pragma unroll
            for (int j = 0; j < 4; ++j) raw[rr][j] = *(const u32x4*)(hT + (size_t)(m0 + 2 * w + rr) * DM + lane * 8 + 512 * j);
#pragma unroll
        for (int rr = 0; rr < 2; ++rr) { const int r = 2 * w + rr, m = m0 + r;
            float v[4][8]; float s = 0.f;
#pragma unroll
            for (int j = 0; j < 4; ++j) unpack8(raw[rr][j], v[j]);
#pragma unroll
            for (int j = 0; j < 4; ++j)
#pragma unroll
                for (int e = 0; e < 8; ++e) s += v[j][e];
            const float mean = wave_sum(s, lane) * (1.f / DM); float s2 = 0.f;
#pragma unroll
            for (int j = 0; j < 4; ++j)
#pragma unroll
                for (int e = 0; e < 8; ++e) { v[j][e] -= mean; s2 += v[j][e] * v[j][e]; }
            const float rstd = 1.f / sqrtf(wave_sum(s2, lane) * (1.f / DM) + LN_EPS);
#pragma unroll
            for (int j = 0; j < 4; ++j) { const int c0 = lane * 8 + 512 * j;
                const f32x4 g0 = *(const f32x4*)(g + c0), g1 = *(const f32x4*)(g + c0 + 4), b0 = *(const f32x4*)(b + c0), b1 = *(const f32x4*)(b + c0 + 4);
#pragma unroll
                for (int e = 0; e < 4; ++e) { v[j][e] = v[j][e] * rstd * g0[e] + b0[e]; v[j][4 + e] = v[j][4 + e] * rstd * g1[e] + b1[e]; }
                st8(hB + (size_t)m * DM + c0, v[j]);
                unsigned hi[8], lo[8];
#pragma unroll
                for (int e = 0; e < 8; ++e) { hi[e] = f2bf(v[j][e]); lo[e] = f2bf(v[j][e] - __uint_as_float(hi[e] << 16)); }
                const int pc = ((lane + 64 * j) ^ r) * 16;
                *(LAS u32x4*)(Hhi + r * 4096 + pc) = (u32x4){hi[0] | (hi[1] << 16), hi[2] | (hi[3] << 16), hi[4] | (hi[5] << 16), hi[6] | (hi[7] << 16)};
                *(LAS u32x4*)(Hlo + r * 4096 + pc) = (u32x4){lo[0] | (lo[1] << 16), lo[2] | (lo[3] << 16), lo[4] | (lo[5] << 16), lo[6] | (lo[7] << 16)}; }
        }
        __syncthreads();
        f32x4 acc = (f32x4){0.f, 0.f, 0.f, 0.f};
#pragma unroll
        for (int ks = 0; ks < 8; ++ks) { const int k = 256 * w + 32 * ks + 8 * gq; const int pc = ((k >> 3) ^ ic) * 16;
            const bf16x8 ahi = *(const LAS bf16x8*)(Hhi + ic * 4096 + pc), alo = *(const LAS bf16x8*)(Hlo + ic * 4096 + pc);
            const bf16x8 bhi = *(const bf16x8*)(wrt + (size_t)ic * DM + k), blo = *(const bf16x8*)(wrt + (size_t)(16 + ic) * DM + k);
            acc = MFMA16(ahi, bhi, acc); acc = MFMA16(ahi, blo, acc); acc = MFMA16(alo, bhi, acc); }
#pragma unroll
        for (int r = 0; r < 4; ++r) part[(w * 16 + 4 * gq + r) * 17 + ic] = acc[r];
        __syncthreads();
        if (w == 0 && lane < 16) {
            const int m = m0 + lane;
            float aff[16], bi[16];
#pragma unroll
            for (int e = 0; e < 16; ++e) { float lg = 0.f;
#pragma unroll
                for (int q = 0; q < 8; ++q) lg += part[(q * 16 + lane) * 17 + e];
                aff[e] = 1.0f / (1.0f + expf(-lg)); bi[e] = aff[e] + rb[e]; }
            int gbest = 0; float gsc = -1e30f;
#pragma unroll
            for (int q = 0; q < 4; ++q) { float m1 = -1e30f, m2 = -1e30f;
#pragma unroll
                for (int i = 0; i < 4; ++i) { const float x = bi[4 * q + i]; if (x > m1) { m2 = m1; m1 = x; } else if (x > m2) m2 = x; }
                const float sc = m1 + m2; if (sc > gsc) { gsc = sc; gbest = q; } }
            int i0 = 0, i1 = 0; float b0 = -1e30f, b1 = -1e30f;
#pragma unroll
            for (int q = 0; q < 4; ++q) if (q == gbest) {
#pragma unroll
                for (int i = 0; i < 4; ++i) { const float x = bi[4 * q + i]; if (x > b0) { b1 = b0; i1 = i0; b0 = x; i0 = i; } else if (x > b1) { b1 = x; i1 = i; } } }
            float a0 = 0.f, a1 = 0.f;
#pragma unroll
            for (int e = 0; e < 16; ++e) { if (e == gbest * 4 + i0) a0 = aff[e]; if (e == gbest * 4 + i1) a1 = aff[e]; }
            const int e0 = gbest * 4 + i0, e1 = gbest * 4 + i1; const float inv = 1.0f / (a0 + a1);
            unsigned* cnt = (unsigned*)(F.ctl + CW_CNT + 64 * l);
            const unsigned p0 = atomicAdd(cnt + e0, 1u), p1 = atomicAdd(cnt + e1, 1u);
            int* tk = WSP(int, WS_TOK) + (size_t)m * 8;
            tk[0] = e0; tk[1] = e1; tk[2] = (int)p0; tk[3] = (int)p1; tk[6] = __float_as_int(a0 * inv); tk[7] = __float_as_int(a1 * inv);
        }
    }
}


__device__ __forceinline__ void phase_router(const Frame& F, int l) {
    const bf16_t* hB = WSP(bf16_t, WS_HB); const bf16_t* wrt = WSP(bf16_t, WS_WRT);
    LAS float* part = (LAS float*)F.lds;
    const int lane = F.lane, w = F.wave, gq = lane >> 4, ic = lane & 15;
    const float* rb = INF(31);
    for (int t2 = F.bid; t2 < NT / 32; t2 += F.G) {
        const int m0 = (t2 * 2 + (w >> 2)) * 16, kbase = (w & 3) * 512;
        f32x4 acc = (f32x4){0.f, 0.f, 0.f, 0.f};
#pragma unroll 8
        for (int ks = 0; ks < 16; ++ks) { const int k = kbase + 32 * ks + 8 * gq;
            const bf16x8 a = *(const bf16x8*)(hB + (size_t)(m0 + ic) * DM + k);
            const bf16x8 bhi = *(const bf16x8*)(wrt + (size_t)ic * DM + k), blo = *(const bf16x8*)(wrt + (size_t)(16 + ic) * DM + k);
            acc = MFMA16(a, bhi, acc); acc = MFMA16(a, blo, acc); }
        __syncthreads();
#pragma unroll
        for (int r = 0; r < 4; ++r) part[(w * 16 + 4 * gq + r) * 17 + ic] = acc[r];
        __syncthreads();
        if ((w & 3) == 0 && lane < 16) {
            const int m = m0 + lane;
            float aff[16], bi[16];
#pragma unroll
            for (int e = 0; e < 16; ++e) { float lg = 0.f;
#pragma unroll
                for (int q = 0; q < 4; ++q) lg += part[((w + q) * 16 + lane) * 17 + e];
                aff[e] = 1.0f / (1.0f + expf(-lg)); bi[e] = aff[e] + rb[e]; }
            int gbest = 0; float gsc = -1e30f;
#pragma unroll
            for (int q = 0; q < 4; ++q) { float m1 = -1e30f, m2 = -1e30f;
#pragma unroll
                for (int i = 0; i < 4; ++i) { const float x = bi[4 * q + i]; if (x > m1) { m2 = m1; m1 = x; } else if (x > m2) m2 = x; }
                const float sc = m1 + m2; if (sc > gsc) { gsc = sc; gbest = q; } }
            int i0 = 0, i1 = 0; float b0 = -1e30f, b1 = -1e30f;
#pragma unroll
            for (int q = 0; q < 4; ++q) if (q == gbest) {
#pragma unroll
                for (int i = 0; i < 4; ++i) { const float x = bi[4 * q + i]; if (x > b0) { b1 = b0; i1 = i0; b0 = x; i0 = i; } else if (x > b1) { b1 = x; i1 = i; } } }
            float a0 = 0.f, a1 = 0.f;
#pragma unroll
            for (int e = 0; e < 16; ++e) { if (e == gbest * 4 + i0) a0 = aff[e]; if (e == gbest * 4 + i1) a1 = aff[e]; }
            const int e0 = gbest * 4 + i0, e1 = gbest * 4 + i1; const float inv = 1.0f / (a0 + a1);
            unsigned* cnt = (unsigned*)(F.ctl + CW_CNT + 64 * l);
            const unsigned p0 = atomicAdd(cnt + e0, 1u), p1 = atomicAdd(cnt + e1, 1u);
            int* tk = WSP(int, WS_TOK) + (size_t)m * 8;
            tk[0] = e0; tk[1] = e1; tk[2] = (int)p0; tk[3] = (int)p1; tk[6] = __float_as_int(a0 * inv); tk[7] = __float_as_int(a1 * inv);
        }
    }
}

__device__ __forceinline__ void phase_p0(const Frame& F) {
    phase_convert(F, 0, 7, F.bid * NWAVES + F.wave, F.G * NWAVES);
    ln_rows<0, false, false>(F, INF(0), INF(3), INF(4), 0);
    const int gt = F.bid * NTHREADS + F.tid, NGT = F.G * NTHREADS;
    const float* mem = INF(1); unsigned char* mb = WSP(unsigned char, WS_MEMB);
    for (int i = gt; i < NMEM * DM / 4; i += NGT) { const f32x4 v = *(const f32x4*)(mem + (size_t)i * 4); *(unsigned*)(mb + (size_t)i * 4) = pk_fp8x4(v[0], v[1], v[2], v[3]); }
    { const float* W = INF(30); bf16_t* wrt = WSP(bf16_t, WS_WRT);
      for (int i = gt; i < DM * 16; i += NGT) { const int k = i >> 4, e = i & 15; const float x = W[i]; const unsigned hi = f2bf(x); const float xl = x - __uint_as_float(hi << 16);
          wrt[(size_t)e * DM + k] = (bf16_t)hi; wrt[(size_t)(16 + e) * DM + k] = (bf16_t)f2bf(xl); } }
    const int* pos = (const int*)ldp(F.lds, 2); f32x2* cs = WSP(f32x2, WS_CS);
    for (int i = gt; i < NT * 32; i += NGT) { const int m = i >> 5, k = i & 31; const float fr = exp2f(-(float)k * (13.287712379549449f / 32.0f)); const float a = (float)pos[m] * fr; cs[i] = (f32x2){cosf(a), sinf(a)}; }
}

__device__ __forceinline__ void phase_tokprep(const Frame& F, int l) {
    constexpr int TB = 1;
    const int gw = F.bid * NWAVES + F.wave, NGW = F.G * NWAVES, lane = F.lane;
    const bf16_t* Z = WSP(bf16_t, WS_Z);
    const float* vg = INF(6) + l * 512, *vb = INF(7) + l * 512, *qg = INF(10) + l * 384, *kvg = INF(11) + l * 256;
    const float* wgate = INF(14) + l * 16 * 256, *bgate = INF(15) + l * 256, *cw = INF(17) + l * 4 * 512, *cb = INF(18) + l * 512, *gb = INF(19) + l * 8;
    const f32x2* cs = WSP(f32x2, WS_CS);
    f32x4 wg[16], cwv[4][2];
#pragma unroll
    for (int r = 0; r < 16; ++r) wg[r] = *(const f32x4*)(wgate + r * 256 + lane * 4);
#pragma unroll
    for (int k = 0; k < 4; ++k) { cwv[k][0] = *(const f32x4*)(cw + k * 512 + lane * 8); cwv[k][1] = *(const f32x4*)(cw + k * 512 + lane * 8 + 4); }
    const f32x4 bg = *(const f32x4*)(bgate + lane * 4), cb0 = *(const f32x4*)(cb + lane * 8), cb1 = *(const f32x4*)(cb + lane * 8 + 4);
    const f32x4 vg0 = *(const f32x4*)(vg + lane * 8), vg1 = *(const f32x4*)(vg + lane * 8 + 4), vb0 = *(const f32x4*)(vb + lane * 8), vb1 = *(const f32x4*)(vb + lane * 8 + 4);
    const f32x4 qg0 = *(const f32x4*)(qg + (lane < 48 ? lane : 0) * 8), qg1 = *(const f32x4*)(qg + (lane < 48 ? lane : 0) * 8 + 4), kg0 = *(const f32x4*)(kvg + (lane & 31) * 8), kg1 = *(const f32x4*)(kvg + (lane & 31) * 8 + 4);
    const float gbl = gb[lane & 7];
    for (int m0 = gw; m0 < NT; m0 += TB * NGW) {
        int mm[TB]; bool ok[TB];
#pragma unroll
        for (int t = 0; t < TB; ++t) { mm[t] = m0 + t * NGW; ok[t] = mm[t] < NT; if (!ok[t]) mm[t] = m0; }
        u32x4 rv[TB], rq[TB], rk[TB], rl0[TB], rl1[TB], cr[TB][4]; unsigned short k1[TB], k2[TB], gz[TB]; f32x2 cc[TB];
        const u32x4 zero4 = (u32x4){0u, 0u, 0u, 0u};
#pragma unroll
        for (int t = 0; t < TB; ++t) { const bf16_t* z = Z + (size_t)mm[t] * ZLD;
            rv[t] = *(const u32x4*)(z + Z_SGV + lane * 8);
            rq[t] = (lane < 48) ? *(const u32x4*)(z + Z_CQ + lane * 8) : zero4;
            rk[t] = (lane < 32) ? *(const u32x4*)(z + Z_CKV + lane * 8) : zero4;
            rl0[t] = *(const u32x4*)(z + Z_LR); rl1[t] = *(const u32x4*)(z + Z_LR + 8);
            k1[t] = z[Z_KR + (lane & 31)]; k2[t] = z[Z_KR + 32 + (lane & 31)]; cc[t] = cs[(size_t)mm[t] * 32 + (lane & 31)]; gz[t] = z[Z_IF + (lane & 7)];
#pragma unroll
            for (int k = 0; k < 4; ++k) cr[t][k] = ((mm[t] & (SEQ - 1)) - 3 + k >= 0) ? *(const u32x4*)(z + (long)(k - 3) * ZLD + Z_MQK + lane * 8) : zero4; }
        float red[TB][4]; float xv[TB][8], xq[TB][8], xk[TB][8];
#pragma unroll
        for (int t = 0; t < TB; ++t) { unpack8(rv[t], xv[t]); unpack8(rq[t], xq[t]); unpack8(rk[t], xk[t]); red[t][0] = red[t][1] = red[t][2] = red[t][3] = 0.f;
#pragma unroll
            for (int j = 0; j < 8; ++j) { red[t][0] += xv[t][j]; red[t][1] += xv[t][j] * xv[t][j]; red[t][2] += xq[t][j] * xq[t][j]; red[t][3] += xk[t][j] * xk[t][j]; } }
#pragma unroll
        for (int o = 1; o < 64; o <<= 1)
#pragma unroll
            for (int t = 0; t < TB; ++t)
#pragma unroll
                for (int i = 0; i < 4; ++i) red[t][i] += shx(red[t][i], o, lane);
#pragma unroll
        for (int t = 0; t < TB; ++t) { if (!ok[t]) continue; const int m = mm[t];
            {
                const float mean = red[t][0] * (1.f / 512.f), var = fmaxf(red[t][1] * (1.f / 512.f) - mean * mean, 0.f), rstd = __builtin_amdgcn_rsqf(var + LN_EPS); float x[8];
#pragma unroll
                for (int j = 0; j < 4; ++j) { x[j] = (xv[t][j] - mean) * rstd * vg0[j] + vb0[j]; x[4 + j] = (xv[t][4 + j] - mean) * rstd * vg1[j] + vb1[j]; }
                st8(WSP(bf16_t, WS_VN) + (size_t)m * 512 + lane * 8, x); }
            if (lane < 48) { const float r = __builtin_amdgcn_rsqf(red[t][2] * (1.f / 384.f) + LN_EPS); float x[8];
#pragma unroll
                for (int j = 0; j < 4; ++j) { x[j] = xq[t][j] * r * qg0[j]; x[4 + j] = xq[t][4 + j] * r * qg1[j]; }
                st8(WSP(bf16_t, WS_CQN) + (size_t)m * 384 + lane * 8, x); }
            if (lane < 32) { const float r2 = __builtin_amdgcn_rsqf(red[t][3] * (1.f / 256.f) + LN_EPS); float x[8];
#pragma unroll
                for (int j = 0; j < 4; ++j) { x[j] = xk[t][j] * r2 * kg0[j]; x[4 + j] = xk[t][4 + j] * r2 * kg1[j]; }
                st8(WSP(bf16_t, WS_CKVN) + (size_t)m * 256 + lane * 8, x); }
            if (lane < 32) {
                const float x1 = bf2f(k1[t]), x2 = bf2f(k2[t]); const f32x2 c = cc[t];
                *(unsigned*)(WSP(bf16_t, WS_KR) + (size_t)m * 64 + 2 * lane) = pk2(x1 * c.x - x2 * c.y, x1 * c.y + x2 * c.x); }
            {
                float lr[16]; unpack8(rl0[t], lr); unpack8(rl1[t], lr + 8);
                f32x4 a = bg;
#pragma unroll
                for (int r = 0; r < 16; ++r) a += wg[r] * lr[r];
                f32x4 o;
#pragma unroll
                for (int j = 0; j < 4; ++j) o[j] = logsigmoidf_(a[j]) * (1.f / 16.f);
                *(f32x4*)(WSP(float, WS_LOGA) + (size_t)m * 256 + lane * 4) = o; }
            {
                float a[8];
#pragma unroll
                for (int j = 0; j < 4; ++j) { a[j] = cb0[j]; a[4 + j] = cb1[j]; }
#pragma unroll
                for (int k = 0; k < 4; ++k) { float x[8]; unpack8(cr[t][k], x);
#pragma unroll
                    for (int j = 0; j < 4; ++j) { a[j] += cwv[k][0][j] * x[j]; a[4 + j] += cwv[k][1][j] * x[4 + j]; } }
                const float sc = (lane < 32) ? 0.125f : 1.0f;
#pragma unroll
                for (int j = 0; j < 8; ++j) a[j] = siluf_(a[j]) * sc;
                bf16_t* dst = (lane < 32) ? (WSP(bf16_t, WS_MQ) + (size_t)m * 256 + lane * 8) : (WSP(bf16_t, WS_MK) + (size_t)m * 256 + (lane - 32) * 8);
                st8(dst, a); }
            if (lane < 8) { const float x = bf2f(gz[t]) + gbl; WSP(float, WS_GIF)[(size_t)m * 8 + lane] = (lane < 4) ? x : logsigmoidf_(x); }
        }
    }
}

__device__ __forceinline__ void sg_item(const Frame& F, int l, int item) {
    const int c = item >> 2, g = item & 3, m0 = c * 128, lane = F.lane, w = F.wave;
    LAS bf16_t* vt = (LAS bf16_t*)F.lds;
    const bf16_t* vn = WSP(bf16_t, WS_VN);
    __syncthreads();
    for (int i = F.tid; i < 128 * 16; i += NTHREADS) { const int s = i >> 4, ch = i & 15; *(LAS u32x4*)(vt + s * 136 + ch * 8) = *(const u32x4*)(vn + (size_t)(m0 + s) * 512 + g * 128 + ch * 8); }
    __syncthreads();
    const float* W = INF(8) + ((size_t)(l * 4 + g) * 128) * 128; const float* bs = INF(9) + (l * 4 + g) * 128;
    const int t = 16 * w + (lane & 15), gq = lane >> 4;
    f32x4 acc[8];
#pragma unroll
    for (int mt = 0; mt < 8; ++mt) acc[mt] = (f32x4){0.f, 0.f, 0.f, 0.f};
    for (int ks = 0; ks < 4; ++ks) {
        if (32 * ks > 16 * w + 15) break;
        const int s0 = 32 * ks + 8 * gq; const f32x4 w0 = *(const f32x4*)(W + (size_t)t * 128 + s0), w1 = *(const f32x4*)(W + (size_t)t * 128 + s0 + 4);
        float wv[8] = {w0[0], w0[1], w0[2], w0[3], w1[0], w1[1], w1[2], w1[3]};
#pragma unroll
        for (int j = 0; j < 8; ++j) if (s0 + j > t) wv[j] = 0.f;
        const u32x4 pw = (u32x4){pk2(wv[0], wv[1]), pk2(wv[2], wv[3]), pk2(wv[4], wv[5]), pk2(wv[6], wv[7])};
        const bf16x8 bfr = __builtin_bit_cast(bf16x8, pw);
#pragma unroll
        for (int mt = 0; mt < 8; ++mt) { const bf16x8 a = frag_tr(vt, 136, 32 * ks, 16 * mt, lane); acc[mt] = MFMA16(a, bfr, acc[mt]); }
    }
    const float bias = bs[t]; const bf16_t* zu = WSP(bf16_t, WS_Z) + (size_t)(m0 + t) * ZLD + Z_SGU + g * 128; unsigned char* yo = WSP(unsigned char, WS_YC8) + (size_t)(m0 + t) * DM + g * 128;
#pragma unroll
    for (int mt = 0; mt < 8; ++mt) { const int d = 16 * mt + 4 * gq; const u32x2 uu = *(const u32x2*)(zu + d);
        f32x4 o; o[0] = lo_bf(uu.x) * (acc[mt][0] + bias); o[1] = hi_bf(uu.x) * (acc[mt][1] + bias); o[2] = lo_bf(uu.y) * (acc[mt][2] + bias); o[3] = hi_bf(uu.y) * (acc[mt][3] + bias);
        *(unsigned*)(yo + d) = pk_fp8x4(o[0], o[1], o[2], o[3]); }
}

__device__ __forceinline__ void gla_cumsum(const Frame& F, LAS float* bt, LAS float* seg, const float* la  ) {
    const int tid = F.tid;
    { const int t = tid >> 3, d8 = (tid & 7) * 8; const f32x4 a = *(const f32x4*)(la + (size_t)t * 256 + d8), b = *(const f32x4*)(la + (size_t)t * 256 + d8 + 4);
      LAS float* p = bt + t * 65 + d8; p[0] = a[0]; p[1] = a[1]; p[2] = a[2]; p[3] = a[3]; p[4] = b[0]; p[5] = b[1]; p[6] = b[2]; p[7] = b[3]; }
    __syncthreads();
    const int d = tid & 63, sg = tid >> 6; float run = 0.f;
#pragma unroll
    for (int j = 0; j < 8; ++j) { run += bt[(sg * 8 + j) * 65 + d]; bt[(sg * 8 + j) * 65 + d] = run; }
    seg[sg * 64 + d] = run;
    __syncthreads();
    float pre = 0.f;
    for (int q = 0; q < sg; ++q) pre += seg[q * 64 + d];
#pragma unroll
    for (int j = 0; j < 8; ++j) bt[(sg * 8 + j) * 65 + d] += pre;
    __syncthreads();
}
__device__ __forceinline__ void gla_pass1(const Frame& F, int item) {
    const int bh = item >> 5, c = item & 31, b = bh >> 2, h = bh & 3, m0 = b * SEQ + c * 64, tid = F.tid, lane = F.lane, w = F.wave;
    LAS float* bt = (LAS float*)F.lds; LAS float* seg = (LAS float*)(F.lds + 16896);
    LAS bf16_t* kd = (LAS bf16_t*)(F.lds + 19456); LAS bf16_t* vt = (LAS bf16_t*)(F.lds + 19456 + 9216);
    const bf16_t* Z = WSP(bf16_t, WS_Z);
    __syncthreads();
    const int s_ = tid >> 3, d8_ = (tid & 7) * 8;
    const u32x4 rk = *(const u32x4*)(Z + (size_t)(m0 + s_) * ZLD + Z_GK + h * 64 + d8_); u32x4 rv[2];
#pragma unroll
    for (int q = 0; q < 2; ++q) { const int ch = (tid & 7) + 8 * q; rv[q] = *(const u32x4*)(Z + (size_t)(m0 + s_) * ZLD + Z_GV + h * 128 + ch * 8); }
    gla_cumsum(F, bt, seg, WSP(float, WS_LOGA) + (size_t)m0 * 256 + h * 64);
    { const int s = s_, d8 = d8_; float x[8] = {lo_bf(rk.x), hi_bf(rk.x), lo_bf(rk.y), hi_bf(rk.y), lo_bf(rk.z), hi_bf(rk.z), lo_bf(rk.w), hi_bf(rk.w)};
#pragma unroll
      for (int j = 0; j < 8; ++j) x[j] *= __expf(bt[63 * 65 + d8 + j] - bt[s * 65 + d8 + j]);
      u32x4 o; o.x = pk2(x[0], x[1]); o.y = pk2(x[2], x[3]); o.z = pk2(x[4], x[5]); o.w = pk2(x[6], x[7]); *(LAS u32x4*)(kd + s * 72 + d8) = o;
#pragma unroll
      for (int q = 0; q < 2; ++q) { const int ch = (tid & 7) + 8 * q; *(LAS u32x4*)(vt + s * 136 + ch * 8) = rv[q]; } }
    if (tid < 64) WSP(float, WS_DEC)[(size_t)item * 64 + tid] = __expf(bt[63 * 65 + tid]);
    __syncthreads();
    const int mt = w & 3, nh = w >> 2, gq = lane >> 4, ic = lane & 15; float* U = WSP(float, WS_UG) + (size_t)item * 64 * 128;
#pragma unroll
    for (int q = 0; q < 4; ++q) { const int nt = nh * 4 + q; f32x4 acc = (f32x4){0.f, 0.f, 0.f, 0.f};
#pragma unroll
        for (int ks = 0; ks < 2; ++ks) acc = MFMA16(frag_tr(kd, 72, 32 * ks, 16 * mt, lane), frag_tr(vt, 136, 32 * ks, 16 * nt, lane), acc);
#pragma unroll
        for (int r = 0; r < 4; ++r) U[(16 * mt + 4 * gq + r) * 128 + 16 * nt + ic] = acc[r]; }
}
__device__ __forceinline__ void gla_scan(const Frame& F) {
    const int gt = F.bid * NTHREADS + F.tid, NGT = F.G * NTHREADS;
    const float* U = WSP(float, WS_UG), *dec = WSP(float, WS_DEC); bf16_t* S = WSP(bf16_t, WS_SG);
    for (int idx = gt; idx < 16 * 8192; idx += NGT) { const int bh = idx >> 13, e = idx & 8191, d = e >> 7; float s = 0.f;
        float uu[32], dd[32];
#pragma unroll
        for (int j = 0; j < 32; ++j) { const size_t it = (size_t)bh * 32 + j; uu[j] = U[it * 8192 + e]; dd[j] = dec[it * 64 + d]; }
#pragma unroll
        for (int j = 0; j < 32; ++j) { const size_t it = (size_t)bh * 32 + j; S[it * 8192 + e] = (bf16_t)f2bf(s); s = s * dd[j] + uu[j]; } }
}
__device__ __forceinline__ void gla_pass2(const Frame& F, int l, int item) {
    const int bh = item >> 5, c = item & 31, b = bh >> 2, h = bh & 3, m0 = b * SEQ + c * 64, tid = F.tid, lane = F.lane, w = F.wave;
    LAS float* bt = (LAS float*)F.lds; LAS float* seg = (LAS float*)(F.lds + 16896);
    LAS bf16_t* qt = (LAS bf16_t*)(F.lds + 19456); LAS bf16_t* kd = qt + 64 * 72; LAS bf16_t* att = kd + 64 * 72;
    LAS bf16_t* vt = att + 64 * 72; LAS bf16_t* st = vt + 64 * 136; LAS float* ot = (LAS float*)(st + 64 * 136);
    const bf16_t* Z = WSP(bf16_t, WS_Z);
    __syncthreads();
    const int s_ = tid >> 3, d8_ = (tid & 7) * 8; const bf16_t* Sg = WSP(bf16_t, WS_SG) + (size_t)item * 8192;
    const u32x4 rq = *(const u32x4*)(Z + (size_t)(m0 + s_) * ZLD + Z_GQ + h * 64 + d8_), rk = *(const u32x4*)(Z + (size_t)(m0 + s_) * ZLD + Z_GK + h * 64 + d8_);
    u32x4 rv[2], rs[2], rog[2];
#pragma unroll
    for (int q = 0; q < 2; ++q) { const int ch = (tid & 7) + 8 * q; rv[q] = *(const u32x4*)(Z + (size_t)(m0 + s_) * ZLD + Z_GV + h * 128 + ch * 8); rs[q] = *(const u32x4*)(Sg + s_ * 128 + ch * 8);
        rog[q] = *(const u32x4*)(Z + (size_t)(m0 + s_) * ZLD + Z_GO + h * 128 + (tid & 7) * 16 + 8 * q); }
    gla_cumsum(F, bt, seg, WSP(float, WS_LOGA) + (size_t)m0 * 256 + h * 64);
    { const int s = s_, d8 = d8_; float x[8] = {lo_bf(rq.x), hi_bf(rq.x), lo_bf(rq.y), hi_bf(rq.y), lo_bf(rq.z), hi_bf(rq.z), lo_bf(rq.w), hi_bf(rq.w)};
      float y[8] = {lo_bf(rk.x), hi_bf(rk.x), lo_bf(rk.y), hi_bf(rk.y), lo_bf(rk.z), hi_bf(rk.z), lo_bf(rk.w), hi_bf(rk.w)};
#pragma unroll
      for (int j = 0; j < 8; ++j) { const float bb = bt[s * 65 + d8 + j]; x[j] *= 0.125f * __expf(bb); y[j] *= __expf(-bb); }
      u32x4 o; o.x = pk2(x[0], x[1]); o.y = pk2(x[2], x[3]); o.z = pk2(x[4], x[5]); o.w = pk2(x[6], x[7]); *(LAS u32x4*)(qt + s * 72 + d8) = o;
      o.x = pk2(y[0], y[1]); o.y = pk2(y[2], y[3]); o.z = pk2(y[4], y[5]); o.w = pk2(y[6], y[7]); *(LAS u32x4*)(kd + s * 72 + d8) = o;
#pragma unroll
      for (int q = 0; q < 2; ++q) { const int ch = (tid & 7) + 8 * q; *(LAS u32x4*)(vt + s * 136 + ch * 8) = rv[q]; *(LAS u32x4*)(st + s * 136 + ch * 8) = rs[q]; } }
    __syncthreads();
    const int mt = w & 3, nh = w >> 2, gq = lane >> 4, ic = lane & 15;
#pragma unroll
    for (int q = 0; q < 2; ++q) { const int nt = nh * 2 + q; f32x4 acc = (f32x4){0.f, 0.f, 0.f, 0.f};
        if (nt <= mt) {
#pragma unroll
            for (int ks = 0; ks < 2; ++ks) acc = MFMA16(frag_rm(qt, 72, 16 * mt, 32 * ks, lane), frag_rm(kd, 72, 16 * nt, 32 * ks, lane), acc); }
#pragma unroll
        for (int r = 0; r < 4; ++r) { const int t = 16 * mt + 4 * gq + r, s = 16 * nt + ic; att[t * 72 + s] = (bf16_t)f2bf(s <= t ? acc[r] : 0.f); } }
    __syncthreads();
#pragma unroll
    for (int q = 0; q < 4; ++q) { const int nt = nh * 4 + q; f32x4 acc = (f32x4){0.f, 0.f, 0.f, 0.f};
#pragma unroll
        for (int ks = 0; ks < 2; ++ks) { acc = MFMA16(frag_rm(att, 72, 16 * mt, 32 * ks, lane), frag_tr(vt, 136, 32 * ks, 16 * nt, lane), acc);
            acc = MFMA16(frag_rm(qt, 72, 16 * mt, 32 * ks, lane), frag_tr(st, 136, 32 * ks, 16 * nt, lane), acc); }
#pragma unroll
        for (int r = 0; r < 4; ++r) ot[(16 * mt + 4 * gq + r) * 132 + 16 * nt + ic] = acc[r]; }
    __syncthreads();
    { const int t = tid >> 3, j0 = (tid & 7) * 16; float o[16]; float ss = 0.f;
#pragma unroll
      for (int j = 0; j < 16; ++j) { o[j] = ot[t * 132 + j0 + j]; ss += o[j] * o[j]; }
      ss += shx(ss, 1, lane); ss += shx(ss, 2, lane); ss += shx(ss, 4, lane);
      const float rstd = 1.f / sqrtf(ss * (1.f / 128.f) + LN_EPS); const float* ng = INF(16) + l * 128 + j0;
      float og[16];
#pragma unroll
      for (int q = 0; q < 2; ++q) { og[8 * q + 0] = lo_bf(rog[q].x); og[8 * q + 1] = hi_bf(rog[q].x); og[8 * q + 2] = lo_bf(rog[q].y); og[8 * q + 3] = hi_bf(rog[q].y); og[8 * q + 4] = lo_bf(rog[q].z); og[8 * q + 5] = hi_bf(rog[q].z); og[8 * q + 6] = lo_bf(rog[q].w); og[8 * q + 7] = hi_bf(rog[q].w); }
#pragma unroll
      for (int j = 0; j < 16; ++j) o[j] = o[j] * rstd * ng[j] * siluf_(og[j]);
      unsigned char* yo = WSP(unsigned char, WS_YC8) + (size_t)(m0 + t) * DM + 1024 + h * 128 + j0; st8_fp8(yo, o); st8_fp8(yo + 8, o + 8); }
}

__device__ __forceinline__ float wave_incl_scan_add(float v, int lane) {
#pragma unroll
    for (int o = 1; o < 64; o <<= 1) { const float t = shi(v, lane >= o ? lane - o : lane); if (lane >= o) v += t; }
    return v;
}
__device__ __forceinline__ float wave_incl_scan_max(float v, int lane) {
#pragma unroll
    for (int o = 1; o < 64; o <<= 1) { const float t = shi(v, lane >= o ? lane - o : lane); if (lane >= o) v = fmaxf(v, t); }
    return v;
}
__device__ __forceinline__ void ml_load_vext(const Frame& F, LAS bf16_t* ve, const bf16_t* vsrc  ) {
    const int tid = F.tid, s = tid >> 3;
#pragma unroll
    for (int q = 0; q < 2; ++q) { const int ch = (tid & 7) + 8 * q; *(LAS u32x4*)(ve + s * 152 + ch * 8) = *(const u32x4*)(vsrc + (size_t)s * ZLD + ch * 8); }
    if ((tid & 7) < 3) { u32x4 o = (u32x4){0u, 0u, 0u, 0u}; if ((tid & 7) == 0) o.x = 0x3F80u; *(LAS u32x4*)(ve + s * 152 + 128 + (tid & 7) * 8) = o; }
}
__device__ __forceinline__ void ml_pass1(const Frame& F, int item) {
    const int bh = item >> 5, c = item & 31, b = bh >> 2, h = bh & 3, m0 = b * SEQ + c * 64, tid = F.tid, lane = F.lane, w = F.wave;
    LAS float* wg = (LAS float*)F.lds;
    LAS bf16_t* kw = (LAS bf16_t*)(F.lds + 1024); LAS bf16_t* ve = kw + 64 * 72;
    const float* gif = WSP(float, WS_GIF);
    __syncthreads();
    const u32x4 rmk = *(const u32x4*)(WSP(bf16_t, WS_MK) + (size_t)(m0 + (tid >> 3)) * 256 + h * 64 + (tid & 7) * 8);
    if (w == 0) { const float f = gif[(size_t)(m0 + lane) * 8 + 4 + h], ig = gif[(size_t)(m0 + lane) * 8 + h];
        const float bc = wave_incl_scan_add(f, lane), bl = shi(bc, 63), lw = bl + ig - bc, ml = wave_max(lw, lane);
        wg[lane] = __expf(lw - ml);
        if (lane == 0) { float* sc = WSP(float, WS_MSC) + (size_t)item * 4; sc[0] = ml; sc[1] = bl; } }
    ml_load_vext(F, ve, WSP(bf16_t, WS_Z) + (size_t)m0 * ZLD + Z_MV + h * 128);
    __syncthreads();
    { const int s = tid >> 3, d8 = (tid & 7) * 8; float x[8]; unpack8(rmk, x); const float ww = wg[s];
#pragma unroll
      for (int j = 0; j < 8; ++j) x[j] *= ww;
      u32x4 o; o.x = pk2(x[0], x[1]); o.y = pk2(x[2], x[3]); o.z = pk2(x[4], x[5]); o.w = pk2(x[6], x[7]); *(LAS u32x4*)(kw + s * 72 + d8) = o; }
    __syncthreads();
    const int mt = w & 3, nh = w >> 2, gq = lane >> 4, ic = lane & 15; float* U = WSP(float, WS_UM) + (size_t)item * 64 * 144;
    const int nt0 = nh ? 5 : 0, nt1 = nh ? 9 : 5;
    for (int nt = nt0; nt < nt1; ++nt) { f32x4 acc = (f32x4){0.f, 0.f, 0.f, 0.f};
#pragma unroll
        for (int ks = 0; ks < 2; ++ks) acc = MFMA16(frag_tr(kw, 72, 32 * ks, 16 * mt, lane), frag_tr(ve, 152, 32 * ks, 16 * nt, lane), acc);
#pragma unroll
        for (int r = 0; r < 4; ++r) U[(16 * mt + 4 * gq + r) * 144 + 16 * nt + ic] = acc[r]; }
}
__device__ __forceinline__ void ml_scan(const Frame& F) {
    const int gt = F.bid * NTHREADS + F.tid, NGT = F.G * NTHREADS;
    const float* U = WSP(float, WS_UM); float* sc = WSP(float, WS_MSC); bf16_t* C = WSP(bf16_t, WS_CG);
    for (int idx = gt; idx < 16 * 9216; idx += NGT) { const int bh = idx / 9216, e = idx % 9216; float cv = 0.f, mm = 0.f;
        float uu[32], ml[32], fc[32];
#pragma unroll
        for (int j = 0; j < 32; ++j) { const size_t it = (size_t)bh * 32 + j; uu[j] = U[it * 9216 + e]; ml[j] = sc[it * 4 + 0]; fc[j] = sc[it * 4 + 1]; }
#pragma unroll
        for (int j = 0; j < 32; ++j) { const size_t it = (size_t)bh * 32 + j;
            C[it * 9216 + e] = (bf16_t)f2bf(cv); if (e == 0) sc[it * 4 + 2] = mm;
            const float mn = fmaxf(fc[j] + mm, ml[j]); cv = __expf(fc[j] + mm - mn) * cv + __expf(ml[j] - mn) * uu[j]; mm = mn; } }
}
__device__ __forceinline__ void ml_pass2(const Frame& F, int l, int item) {
    const int bh = item >> 5, c = item & 31, b = bh >> 2, h = bh & 3, m0 = b * SEQ + c * 64, tid = F.tid, lane = F.lane, w = F.wave;
    LAS float* av = (LAS float*)F.lds; LAS float* Mv = av + 64; LAS float* wi = Mv + 64; LAS float* cl = wi + 64;
    LAS bf16_t* qt = (LAS bf16_t*)(F.lds + 1024); LAS bf16_t* kt = qt + 64 * 72; LAS bf16_t* sm = kt + 64 * 72;
    LAS bf16_t* ve = sm + 64 * 72; LAS bf16_t* ce = ve + 64 * 152; LAS float* ot = (LAS float*)(ce + 64 * 152);
    const float* gif = WSP(float, WS_GIF);
    __syncthreads();
    u32x4 rog[2];
#pragma unroll
    for (int q = 0; q < 2; ++q) rog[q] = *(const u32x4*)(WSP(bf16_t, WS_Z) + (size_t)(m0 + (tid >> 3)) * ZLD + Z_MO + h * 128 + (tid & 7) * 16 + 8 * q);
    if (w == 0) { const float f = gif[(size_t)(m0 + lane) * 8 + 4 + h], ig = gif[(size_t)(m0 + lane) * 8 + h];
        const float bc = wave_incl_scan_add(f, lane), a = ig - bc, pm = wave_incl_scan_max(a, lane), mp = WSP(float, WS_MSC)[(size_t)item * 4 + 2], M = fmaxf(mp, pm);
        av[lane] = a; Mv[lane] = M; wi[lane] = __expf(mp - M); cl[lane] = __expf(-(bc + M)); }
    ml_load_vext(F, ve, WSP(bf16_t, WS_Z) + (size_t)m0 * ZLD + Z_MV + h * 128);
    { const int s = tid >> 3, d8 = (tid & 7) * 8;
      *(LAS u32x4*)(qt + s * 72 + d8) = *(const u32x4*)(WSP(bf16_t, WS_MQ) + (size_t)(m0 + s) * 256 + h * 64 + d8);
      *(LAS u32x4*)(kt + s * 72 + d8) = *(const u32x4*)(WSP(bf16_t, WS_MK) + (size_t)(m0 + s) * 256 + h * 64 + d8);
      const bf16_t* Cg = WSP(bf16_t, WS_CG) + (size_t)item * 9216;
      for (int i = tid; i < 64 * 18; i += NTHREADS) { const int r = i / 18, ch = i % 18; *(LAS u32x4*)(ce + r * 152 + ch * 8) = *(const u32x4*)(Cg + r * 144 + ch * 8); } }
    __syncthreads();
    const int mt = w & 3, nh = w >> 2, gq = lane >> 4, ic = lane & 15;
#pragma unroll
    for (int q = 0; q < 2; ++q) { const int nt = nh * 2 + q; f32x4 acc = (f32x4){0.f, 0.f, 0.f, 0.f};
        if (nt <= mt) {
#pragma unroll
            for (int ks = 0; ks < 2; ++ks) acc = MFMA16(frag_rm(qt, 72, 16 * mt, 32 * ks, lane), frag_rm(kt, 72, 16 * nt, 32 * ks, lane), acc); }
        const int s = 16 * nt + ic; const float as = av[s];
#pragma unroll
        for (int r = 0; r < 4; ++r) { const int t = 16 * mt + 4 * gq + r; sm[t * 72 + s] = (bf16_t)f2bf(s <= t ? acc[r] * __expf(as - Mv[t]) : 0.f); } }
    __syncthreads();
    { const int nt0 = nh ? 5 : 0, nt1 = nh ? 9 : 5;
      for (int nt = nt0; nt < nt1; ++nt) { f32x4 a1 = (f32x4){0.f, 0.f, 0.f, 0.f}, a2 = a1;
#pragma unroll
        for (int ks = 0; ks < 2; ++ks) { a1 = MFMA16(frag_rm(sm, 72, 16 * mt, 32 * ks, lane), frag_tr(ve, 152, 32 * ks, 16 * nt, lane), a1);
            a2 = MFMA16(frag_rm(qt, 72, 16 * mt, 32 * ks, lane), frag_tr(ce, 152, 32 * ks, 16 * nt, lane), a2); }
#pragma unroll
        for (int r = 0; r < 4; ++r) { const int t = 16 * mt + 4 * gq + r; ot[t * 148 + 16 * nt + ic] = a1[r] + wi[t] * a2[r]; } } }
    __syncthreads();
    { const int t = tid >> 3, j0 = (tid & 7) * 16; float o[16]; float ss = 0.f; const float den = ot[t * 148 + 128], dn = 1.0f / fmaxf(fabsf(den), cl[t]);
#pragma unroll
      for (int j = 0; j < 16; ++j) { o[j] = ot[t * 148 + j0 + j] * dn; ss += o[j] * o[j]; }
      ss += shx(ss, 1, lane); ss += shx(ss, 2, lane); ss += shx(ss, 4, lane);
      const float rstd = 1.f / sqrtf(ss * (1.f / 128.f) + LN_EPS); const float* ng = INF(20) + l * 128 + j0; const bf16_t* Z = WSP(bf16_t, WS_Z);
      float og[16]; unpack8(rog[0], og); unpack8(rog[1], og + 8);
#pragma unroll
      for (int j = 0; j < 16; ++j) o[j] = o[j] * rstd * ng[j] * sigmoidf_(og[j]);
      unsigned char* yo = WSP(unsigned char, WS_YC8) + (size_t)(m0 + t) * DM + 1536 + h * 128 + j0; st8_fp8(yo, o); st8_fp8(yo + 8, o + 8); }
}

template <int DQK, bool CAUSAL, int QP, int MT, bool OUT8>
__device__ __forceinline__ void attn_block(const Frame& F, const void* Qv, int qld, size_t qpstride, float qscale, const bf16_t* Kp, int kld, const bf16_t* Kr, int krld, const bf16_t* V, int vld, bf16_t* O, int old_, int q0, int nkt) {
    constexpr int KS = DQK + 8, NKS = DQK / 32, BUFB = 64 * KS * 2 + 64 * 136 * 2;
    const int tid = F.tid, lane = F.lane, w = F.wave, gq = lane >> 4, ic = lane & 15;
    const int qw = q0 + 16 * MT * w;
    bf16x8 qf[MT][NKS];
#pragma unroll
    for (int mt = 0; mt < MT; ++mt) {
        if constexpr (QP == 0) { const bf16_t* Q = (const bf16_t*)Qv;
#pragma unroll
            for (int ks = 0; ks < NKS; ++ks) qf[mt][ks] = *(const bf16x8*)(Q + (size_t)(qw + 16 * mt + ic) * qld + 32 * ks + 8 * gq);
        } else { const bf16_t* Q = (const bf16_t*)Qv;
#pragma unroll
            for (int ks = 0; ks < NKS; ++ks) { float a[8] = {0.f, 0.f, 0.f, 0.f, 0.f, 0.f, 0.f, 0.f};
#pragma unroll
                for (int p = 0; p < QP; ++p) { float t_[8]; ld8(Q + (size_t)p * qpstride + (size_t)(qw + 16 * mt + ic) * qld + 32 * ks + 8 * gq, t_);
#pragma unroll
                    for (int e = 0; e < 8; ++e) a[e] += t_[e]; }
                const u32x4 pk = (u32x4){pk2(a[0] * qscale, a[1] * qscale), pk2(a[2] * qscale, a[3] * qscale), pk2(a[4] * qscale, a[5] * qscale), pk2(a[6] * qscale, a[7] * qscale)}; qf[mt][ks] = __builtin_bit_cast(bf16x8, pk); } } }
    f32x4 o[MT][8]; float mcol[MT], lcol[MT];
#pragma unroll
    for (int mt = 0; mt < MT; ++mt) { mcol[mt] = -INFINITY; lcol[mt] = 0.f;
#pragma unroll
        for (int i = 0; i < 8; ++i) o[mt][i] = (f32x4){0.f, 0.f, 0.f, 0.f}; }
    constexpr bool ROPE = (DQK > 128);
    u32x4 kreg[2], rreg, vreg[2];
    const int ok_g = (tid >> 4) * kld + (tid & 15) * 8, ov_g = (tid >> 4) * vld + (tid & 15) * 8, or_g = ROPE ? ((tid >> 3) * krld + (tid & 7) * 8) : 0;
    const int ok_l = (tid >> 4) * KS + (tid & 15) * 8, ov_l = (tid >> 4) * 136 + (tid & 15) * 8, or_l = (tid >> 3) * KS + 128 + (tid & 7) * 8;
#define ATT_LOAD(t) do { const bf16_t* kb_ = Kp + (size_t)((t) * 64) * kld; const bf16_t* vb_ = V + (size_t)((t) * 64) * vld; \
        kreg[0] = *(const u32x4*)(kb_ + ok_g); kreg[1] = *(const u32x4*)(kb_ + 32 * kld + ok_g); vreg[0] = *(const u32x4*)(vb_ + ov_g); vreg[1] = *(const u32x4*)(vb_ + 32 * vld + ov_g); \
        if constexpr (ROPE) rreg = *(const u32x4*)(Kr + (size_t)((t) * 64) * krld + or_g); } while (0)
#define ATT_STORE(buf) do { LAS bf16_t* kt_ = (LAS bf16_t*)(F.lds + (buf) * BUFB); LAS bf16_t* vt_ = kt_ + 64 * KS; \
        *(LAS u32x4*)(kt_ + ok_l) = kreg[0]; *(LAS u32x4*)(kt_ + 32 * KS + ok_l) = kreg[1]; *(LAS u32x4*)(vt_ + ov_l) = vreg[0]; *(LAS u32x4*)(vt_ + 32 * 136 + ov_l) = vreg[1]; \
        if constexpr (ROPE) *(LAS u32x4*)(kt_ + or_l) = rreg; } while (0)
    __syncthreads();
    ATT_LOAD(0); ATT_STORE(0);
    __syncthreads();
    for (int t = 0; t < nkt; ++t) {
        const int key0 = t * 64; const bool more = (t + 1 < nkt);
        if (more) ATT_LOAD(t + 1);
        const LAS bf16_t* kt = (const LAS bf16_t*)(F.lds + (t & 1) * BUFB); const LAS bf16_t* vt = kt + 64 * KS;
        f32x4 st[MT][4];
#pragma unroll
        for (int nt = 0; nt < 4; ++nt) {
#pragma unroll
            for (int mt = 0; mt < MT; ++mt) st[mt][nt] = (f32x4){0.f, 0.f, 0.f, 0.f};
#pragma unroll
            for (int ks = 0; ks < NKS; ++ks) { const bf16x8 kf = frag_rm(kt, KS, 16 * nt, 32 * ks, lane);
#pragma unroll
                for (int mt = 0; mt < MT; ++mt) st[mt][nt] = MFMA16(kf, qf[mt][ks], st[mt][nt]); }
            if (MT > 1) __builtin_amdgcn_sched_barrier(0); }
        bf16x8 pf[MT][2];
#pragma unroll
        for (int mt = 0; mt < MT; ++mt) {
            if (CAUSAL && key0 + 63 > qw + 16 * mt) {
#pragma unroll
                for (int nt = 0; nt < 4; ++nt)
#pragma unroll
                    for (int r = 0; r < 4; ++r) if (key0 + 16 * nt + 4 * gq + r > qw + 16 * mt + ic) st[mt][nt][r] = -INFINITY; }
            float mx = -INFINITY;
#pragma unroll
            for (int nt = 0; nt < 4; ++nt) mx = fmaxf(fmaxf(mx, fmaxf(st[mt][nt][0], st[mt][nt][1])), fmaxf(st[mt][nt][2], st[mt][nt][3]));
            mx = fmaxf(mx, shx(mx, 16, lane)); mx = fmaxf(mx, shx(mx, 32, lane));
            const float mn = (mx > mcol[mt] + 11.54f) ? mx : mcol[mt], al = __builtin_amdgcn_exp2f(mcol[mt] - mn); mcol[mt] = mn; float psum = 0.f;
#pragma unroll
            for (int nt = 0; nt < 4; ++nt)
#pragma unroll
                for (int r = 0; r < 4; ++r) { const float p = __builtin_amdgcn_exp2f(st[mt][nt][r] - mn); st[mt][nt][r] = p; psum += p; }
            lcol[mt] = lcol[mt] * al + psum;
#pragma unroll
            for (int ks = 0; ks < 2; ++ks) { const u32x4 pk = (u32x4){pk2(st[mt][2 * ks][0], st[mt][2 * ks][1]), pk2(st[mt][2 * ks][2], st[mt][2 * ks][3]), pk2(st[mt][2 * ks + 1][0], st[mt][2 * ks + 1][1]), pk2(st[mt][2 * ks + 1][2], st[mt][2 * ks + 1][3])};
                pf[mt][ks] = __builtin_bit_cast(bf16x8, pk); }
            if (__builtin_amdgcn_ballot_w64(al != 1.0f)) {
                float ar[4];
#pragma unroll
                for (int r = 0; r < 4; ++r) ar[r] = shi(al, 4 * gq + r);
#pragma unroll
                for (int i = 0; i < 8; ++i) { o[mt][i][0] *= ar[0]; o[mt][i][1] *= ar[1]; o[mt][i][2] *= ar[2]; o[mt][i][3] *= ar[3]; } }
        }
#pragma unroll
        for (int ks = 0; ks < 2; ++ks) { const LAS bf16_t* vp = vt + (32 * ks + 4 * gq + (ic >> 2)) * 136 + 4 * (ic & 3);
#pragma unroll
            for (int nv = 0; nv < 8; ++nv) {
                const s16x4 a = __builtin_bit_cast(s16x4, __builtin_amdgcn_ds_read_tr16_b64_v4i16((LAS s16x4*)(vp + 16 * nv)));
                const s16x4 b = __builtin_bit_cast(s16x4, __builtin_amdgcn_ds_read_tr16_b64_v4i16((LAS s16x4*)(vp + 16 * nv + 16 * 136)));
                const bf16x8 vf = (bf16x8){a[0], a[1], a[2], a[3], b[0], b[1], b[2], b[3]};
#pragma unroll
                for (int mt = 0; mt < MT; ++mt) o[mt][nv] = MFMA16(pf[mt][ks], vf, o[mt][nv]);
                if (MT > 1 && (nv & 1)) __builtin_amdgcn_sched_barrier(0); } }
        if (more) ATT_STORE((t + 1) & 1);
        __syncthreads();
    }
#undef ATT_LOAD
#undef ATT_STORE
    LAS bf16_t* ost = (LAS bf16_t*)(F.lds + w * (16 * 136 * 2));
#pragma unroll
    for (int mt = 0; mt < MT; ++mt) {
        float lsum = lcol[mt]; lsum += shx(lsum, 16, lane); lsum += shx(lsum, 32, lane);
        const float linv = 1.0f / lsum;
#pragma unroll
        for (int r = 0; r < 4; ++r) { const float inv = shi(linv, 4 * gq + r);
#pragma unroll
            for (int nv = 0; nv < 8; ++nv) ost[(4 * gq + r) * 136 + 16 * nv + ic] = (bf16_t)f2bf(o[mt][nv][r] * inv); }
        asm volatile("s_waitcnt lgkmcnt(0)" ::: "memory"); __builtin_amdgcn_wave_barrier();
#pragma unroll
        for (int j = 0; j < 4; ++j) { const int rr = lane >> 2, ch = (lane & 3) + 4 * j; const u32x4 ow = *(const LAS u32x4*)(ost + rr * 136 + ch * 8);
            if constexpr (OUT8) { float f_[8]; unpack8(ow, f_); st8_fp8((unsigned char*)O + (size_t)(qw + 16 * mt + rr) * old_ + ch * 8, f_); }
            else *(u32x4*)(O + (size_t)(qw + 16 * mt + rr) * old_ + ch * 8) = ow; }
        asm volatile("s_waitcnt lgkmcnt(0)" ::: "memory"); __builtin_amdgcn_wave_barrier();
    }
}

struct Args { const void* in[37]; float* out; unsigned char* ws; int ph, layer; };
__device__ __forceinline__ Frame mk_frame(LAS unsigned char* lds_in, int wave_in) {
    Frame F; int wv = wave_in, bid = blockIdx.x; unsigned la = (unsigned)(uintptr_t)lds_in;
    asm volatile("" : "+s"(wv)); asm volatile("" : "+s"(bid)); asm volatile("" : "+s"(la));
    LAS unsigned char* lds = (LAS unsigned char*)(uintptr_t)la;
    const int ln = lane_id();
    unsigned char* ws = (unsigned char*)ldp(lds, 38);
    F.lds = lds; F.tid = wv * 64 + ln; F.lane = ln; F.wave = wv; F.G = gridDim.x; F.bid = bid;
    F.ws = ws; F.out = (float*)ldp(lds, 37); F.ctl = (gu32*)(ws + WS_CTL);
    return F;
}
__device__ __forceinline__ void ptr_table_init(const Args& args, LAS unsigned char* lds) {
    if (threadIdx.x < 39) { const int k = threadIdx.x; const void* p = (k < 37) ? args.in[k] : (k == 37 ? (const void*)args.out : (const void*)args.ws);
        *(LAS unsigned long long*)(lds + PTR_OFF + 8 * k) = (unsigned long long)p; }
    __syncthreads();
}
#define NEWF() const Frame F = mk_frame(lds, wave0)
constexpr int NPH = 18;
template <int PH>
__device__ __forceinline__ void run_phase(LAS unsigned char* lds, int wave0, int l) {
    using namespace pg8;
    if constexpr (PH == 0) { }
    else if constexpr (PH == 1) {
        { NEWF(); StaticOrder S; S.init(WSP(unsigned char, WS_HB8), DM / 2, WSW(unsigned char, WS_WG8, l), DM / 2, NT, 8192, F.G, F.bid);
          EpiGate E{WSP(unsigned char, WS_GQ)}; gemm_phase(F.lds, F.tid, DM / 2, DM / 2, DM / 2, S, E); }
        { NEWF(); StaticOrder S; S.init(WSP(unsigned char, WS_HB8), DM / 2, WSW(unsigned char, WS_WIN, l), DM / 2, NT, 19 * 256, F.G, F.bid); S.skip_from = 16; S.skip_by = 32;
          EpiInProjT<true> E{WSP(bf16_t, WS_Z)}; gemm_phase(F.lds, F.tid, DM / 2, DM / 2, DM / 2, S, E); }
        { NEWF(); StaticOrder S2; S2.init(WSP(unsigned char, WS_MEMB), DM / 2, WSW(unsigned char, WS_WXKV, l), DM / 2, NMEM, 1024, F.G, (F.bid + F.G - 96) % F.G);
          EpiBf16T<true> E2{WSP(bf16_t, WS_XKV), 1024, 1.0f / 64.0f}; gemm_phase(F.lds, F.tid, DM / 2, DM / 2, DM / 2, S2, E2); }
        if (l + 1 < DEPTH && (int)blockIdx.x >= 112) { NEWF(); phase_convert(F, l + 1, 1, (F.bid - 112) * NWAVES + F.wave, (F.G - 112) * NWAVES); }
    }
    else if constexpr (PH == 2) { NEWF(); phase_tokprep(F, l); }
    else if constexpr (PH == 3) {
        { NEWF(); StaticOrder S; S.init(WSP(bf16_t, WS_CQN), 384, WSW(bf16_t, WS_WUQ, l), 384, NT, 768, F.G, F.bid);
          EpiQ E{WSP(bf16_t, WS_Q), WSP(f32x2, WS_CS), 0.07216878364870322f * LOG2E}; gemm_phase(F.lds, F.tid, 384, 384, 384, S, E); }
        { NEWF(); StaticOrder S; S.init(WSP(bf16_t, WS_CKVN), 256, WSW(bf16_t, WS_WUKV, l), 256, NT, 1024, F.G, (F.bid + F.G - 96) % F.G);
          EpiKV E{WSP(bf16_t, WS_KN), WSP(bf16_t, WS_V)}; gemm_phase(F.lds, F.tid, 256, 256, 256, S, E); }
        { NEWF(); for (int it = F.bid; it < 256; it += F.G) sg_item(F, l, it); }
        { NEWF(); for (int it = F.bid; it < 512; it += F.G) gla_pass1(F, it); }
        { NEWF(); for (int it = F.bid; it < 512; it += F.G) ml_pass1(F, it); }
    }
    else if constexpr (PH == 4) { NEWF(); gla_scan(F); ml_scan(F); }
    else if constexpr (PH == 5) {
        { NEWF();
          for (int u = F.bid; u < 256; u += F.G) { const int qb = 15 - (u >> 4), bh = u & 15, b = bh >> 2, h = bh & 3; const size_t r0 = (size_t)b * SEQ;
              attn_block<192, true, 0, 1, true>(F, WSP(bf16_t, WS_Q) + r0 * 768 + h * 192, 768, 0, 1.f, WSP(bf16_t, WS_KN) + r0 * 512 + h * 128, 512, WSP(bf16_t, WS_KR) + r0 * 64, 64,
                                          WSP(bf16_t, WS_V) + r0 * 512 + h * 128, 512, (bf16_t*)(WSP(unsigned char, WS_YC8) + r0 * DM + 512 + h * 128), DM, qb * 128, 2 * (qb + 1)); } }
        { NEWF(); LAS int* qi = (LAS int*)(F.lds + MOE_TAB_OFF); unsigned* qc = (unsigned*)(F.ctl + CW_Q5 + 64 * l);
          if (F.tid == 0) qi[0] = (int)atomicAdd(qc, 1u);
          for (int cur = 0;; cur ^= 1) { __syncthreads(); const int it = qi[cur]; if (it >= 1024) break;
              if (F.tid == 0) qi[cur ^ 1] = (int)atomicAdd(qc, 1u);
              if (it < 512) gla_pass2(F, l, it); else ml_pass2(F, l, it - 512); } }
    }
    else if constexpr (PH == 6) {
        NEWF(); BranchOrder S; S.S0.init(WSP(unsigned char, WS_YC8), DM / 2, WSW(unsigned char, WS_WBR, l), DM / 2, NT, DM, F.G, F.bid); S.A = S.S0.A; S.B = S.S0.B; S.ks = 512;
        EpiBranch8 E{WSP(unsigned char, WS_MRG), WSP(unsigned char, WS_GQ)}; gemm_phase(F.lds, F.tid, DM / 2, DM / 2, 256, S, E);
    }
    else if constexpr (PH == 7) {
        NEWF(); StaticOrder S; S.init(WSP(unsigned char, WS_MRG), DM / 2, WSW(unsigned char, WS_WOUT, l), DM / 2, NT, DM, F.G, F.bid);
        EpiResidLNT<true> E{WSP(bf16_t, WS_HB), INF(23) + l * DM, INF(24) + l * DM, WSP(unsigned long long, WS_LNX) + (size_t)l * 32 * 256 * 8, (unsigned*)(F.ctl + CW_LN1 + 64 * 32 * l), F.lds, WSP(unsigned char, WS_HB8)};
        gemm_phase(F.lds, F.tid, DM / 2, DM / 2, DM / 2, S, E);
    }
    else if constexpr (PH == 8) { NEWF(); ln_rows<1, false, false>(F, nullptr, INF(23) + l * DM, INF(24) + l * DM, l); }
    else if constexpr (PH == 9) {
        NEWF(); SplitKOrder S; S.init(WSP(unsigned char, WS_HB8), DM / 2, WSW(unsigned char, WS_WXQ, l), DM / 2, NT, 512, 256, 4, F.G, F.bid);
        EpiBf16P E{WSP(bf16_t, WS_XQP), 512, (size_t)NT * 512}; gemm_phase(F.lds, F.tid, DM / 2, DM / 2, 256, S, E);
    }
    else if constexpr (PH == 10) {
        NEWF();
        for (int u = F.bid; u < 256; u += F.G) { const int bh = u >> 4, qb = u & 15, b = bh >> 2, h = bh & 3;
            attn_block<128, false, 4, 1, true>(F, WSP(bf16_t, WS_XQP) + (size_t)b * SEQ * 512 + h * 128, 512, (size_t)NT * 512, 0.08838834764831845f * LOG2E, WSP(bf16_t, WS_XKV) + (size_t)b * MEMLEN * 1024 + h * 128, 1024, nullptr, 0,
                                      WSP(bf16_t, WS_XKV) + (size_t)b * MEMLEN * 1024 + 512 + h * 128, 1024, (bf16_t*)(WSP(unsigned char, WS_XO) + (size_t)b * SEQ * 512 + h * 128), 512, qb * 128, 4); }
    }
    else if constexpr (PH == 11) {
        NEWF(); StaticOrder S; S.init(WSP(unsigned char, WS_XO), 256, WSW(unsigned char, WS_WXO, l), 256, NT, DM, F.G, F.bid);
        EpiResidLNT<true> E{WSP(bf16_t, WS_HB), INF(28) + l * DM, INF(29) + l * DM, WSP(unsigned long long, WS_LNX) + (size_t)(4 + l) * 32 * 256 * 8, (unsigned*)(F.ctl + CW_LN1 + 64 * 32 * (4 + l)), F.lds, WSP(unsigned char, WS_HB8)};
        gemm_phase(F.lds, F.tid, 256, 256, 256, S, E);
    }
    else if constexpr (PH == 12) { NEWF(); phase_router(F, l); }
    else if constexpr (PH == 13) { }
    else if constexpr (PH == 14) { }
    else if constexpr (PH == 15) {
        NEWF(); LAS int* off = (LAS int*)(F.lds + MOE_TAB_OFF); LAS int* rt2e = off + 32; LAS int* rowtok = (LAS int*)(F.lds + ROWTAB_OFF); LAS float* roww = (LAS float*)(rowtok + 512);
        moe_offsets(F, l, off, rt2e);
        const int nrt = off[16] >> 8;
        { const int rt0 = (F.bid < nrt * 4) ? F.bid / 4 : -1, rt1 = (F.bid + F.G < nrt * 4) ? (F.bid + F.G) / 4 : -1;
          for (int i = F.tid; i < 512; i += NTHREADS) { rowtok[i] = 0; roww[i] = 0.f; }
          __syncthreads();
          const int* tk = WSP(int, WS_TOK);
          for (int m = F.tid; m < NT; m += NTHREADS) { const int e0 = tk[m * 8 + 0], e1 = tk[m * 8 + 1], r0 = off[e0] + tk[m * 8 + 2], r1 = off[e1] + tk[m * 8 + 3];
              if ((r0 >> 8) == rt0) { rowtok[r0 & 255] = m; roww[r0 & 255] = __int_as_float(tk[m * 8 + 6]); }
              if ((r0 >> 8) == rt1) { rowtok[256 + (r0 & 255)] = m; roww[256 + (r0 & 255)] = __int_as_float(tk[m * 8 + 6]); }
              if ((r1 >> 8) == rt0) { rowtok[r1 & 255] = m; roww[r1 & 255] = __int_as_float(tk[m * 8 + 7]); }
              if ((r1 >> 8) == rt1) { rowtok[256 + (r1 & 255)] = m; roww[256 + (r1 & 255)] = __int_as_float(tk[m * 8 + 7]); } }
          __syncthreads(); }
        MoeGatherOrder S{F.G, F.bid, 4, nrt, (const char*)WSP(unsigned char, WS_HB8), (const char*)WSW(unsigned char, WS_WGU, l), (size_t)256 * DM, (size_t)1024 * DM, rt2e, rowtok, (unsigned)DM};
        EpiGU E{WSP(unsigned char, WS_HID), roww}; gemm_phase(F.lds, F.tid, DM / 2, DM / 2, DM / 2, S, E);
        { const int extra = nrt * 4 - F.G, first = extra > 0 ? (extra < F.G - 32 ? extra : F.G - 32) : 0;
          if (l + 1 < DEPTH && (int)blockIdx.x >= first) { NEWF(); phase_convert(F, l + 1, 2, (F.bid - first) * NWAVES + F.wave, (F.G - first) * NWAVES); } }
    }
    else if constexpr (PH == 16) {
        NEWF(); LAS int* off = (LAS int*)(F.lds + MOE_TAB_OFF); LAS int* rt2e = off + 32;
        moe_offsets(F, l, off, rt2e);
        MoeOrder S{F.G, F.bid, 8, off[16] >> 8, (const char*)WSP(unsigned char, WS_HID), (const char*)WSW(unsigned char, WS_WD, l), (size_t)256 * 512, (size_t)256 * 512, (size_t)DM * 512, rt2e};
        EpiFp8T E{WSP(unsigned char, WS_YD), DM, 16.0f / 64.0f}; gemm_phase(F.lds, F.tid, 256, 256, 256, S, E);
        { const int units = (off[16] >> 8) * 8, rem = units % F.G, first = (rem > 0 && rem < F.G - 32) ? rem : 0;
          if (l + 1 < DEPTH && (int)blockIdx.x >= first) { NEWF(); phase_convert(F, l + 1, 4, (F.bid - first) * NWAVES + F.wave, (F.G - first) * NWAVES); } }
    }
    else if constexpr (PH == 17) { NEWF(); if (l == DEPTH - 1) ln_rows<2, false, true>(F, nullptr, INF(35) + l * DM, INF(36) + l * DM, l); else ln_rows<2, false, false>(F, nullptr, INF(35) + l * DM, INF(36) + l * DM, l); }
}

#if !MK_MULTI
__global__ void __launch_bounds__(NTHREADS, 2) mega_fwd(Args args) {
    extern __shared__ __attribute__((aligned(16))) unsigned char lds_raw[];
    LAS unsigned char* lds = (LAS unsigned char*)lds_raw;
    const int wave0 = __builtin_amdgcn_readfirstlane((int)(threadIdx.x >> 6));
    volatile LAS unsigned* MISC = (volatile LAS unsigned*)(lds + MISC_OFF);
    for (int u = threadIdx.x; u < (LDS_BYTES - RING_BYTES) / 4; u += NTHREADS) ((LAS unsigned*)(lds + RING_BYTES))[u] = 0u;
    __syncthreads();
    ptr_table_init(args, lds);
    const unsigned bar_x = xcd_barrier_post((unsigned*)(args.ws + WS_CTL) + CW_BAR, MISC + 8).x;
#define GB() do { XcdBarrier b_; b_.bar = (unsigned*)((unsigned char*)ldp(lds, 38) + WS_CTL) + CW_BAR; unsigned xx_ = bar_x; asm volatile("" : "+s"(xx_)); b_.x = xx_; b_.st = MISC + 8; \
    xcd_barrier(b_, wave0 * 64 + lane_id()); } while (0)
    { NEWF(); phase_p0(F); } GB();
#pragma unroll 1
    for (int l = 0; l < DEPTH; ++l) {
#define RUNP(k) do { run_phase<k>(lds, wave0, l); GB(); if ((REP_MASK >> k) & 1u) { run_phase<k>(lds, wave0, l); GB(); } } while (0)
        RUNP(1); RUNP(2); RUNP(3); RUNP(4); RUNP(5); RUNP(6); RUNP(7); RUNP(9); RUNP(10); RUNP(11); RUNP(12); RUNP(15); RUNP(16); run_phase<17>(lds, wave0, l); if (l + 1 < DEPTH) GB();
    }
}
#else
template <int PH> __global__ void __launch_bounds__(NTHREADS, 2) k_phase(Args args) {
    extern __shared__ __attribute__((aligned(16))) unsigned char lds_raw[];
    LAS unsigned char* lds = (LAS unsigned char*)lds_raw;
    const int wave0 = __builtin_amdgcn_readfirstlane((int)(threadIdx.x >> 6));
    ptr_table_init(args, lds);
    if constexpr (PH < 0) { NEWF(); phase_p0(F); } else run_phase<PH>(lds, wave0, args.layer);
}
template <int PH> static void launch_ph(const Args& a, hipStream_t st) {
    static bool init = false; if (!init) { (void)hipFuncSetAttribute((const void*)k_phase<PH>, hipFuncAttributeMaxDynamicSharedMemorySize, LDS_BYTES); init = true; }
    k_phase<PH><<<256, NTHREADS, LDS_BYTES, st>>>(a);
}
#endif

extern "C" void kernel_launch(void* const* d_in, const int* in_sizes, int n_in, void* d_out, int out_size, void* d_ws, size_t ws_size, hipStream_t stream) {
    if (n_in != 37 || out_size != NT * DM || ws_size < WS_END) { fprintf(stderr, "kernel_launch: unexpected problem (n_in %d out %d ws %zu need %zu)\n", n_in, out_size, ws_size, (size_t)WS_END); return; }
    (void)hipMemsetAsync((char*)d_ws + WS_CTL, 0, CTL_ZERO_BYTES, stream);
    Args a{};
    for (int i = 0; i < 37; ++i) a.in[i] = d_in[i];
    a.out = (float*)d_out; a.ws = (unsigned char*)d_ws; a.ph = 0; a.layer = 0;
#if !MK_MULTI
    static int grid = 0;
    if (grid == 0) {
        int dev = 0, cus = 0;
        (void)hipGetDevice(&dev); (void)hipDeviceGetAttribute(&cus, hipDeviceAttributeMultiprocessorCount, dev);
        if (hipFuncSetAttribute((const void*)mega_fwd, hipFuncAttributeMaxDynamicSharedMemorySize, LDS_BYTES) != hipSuccess) { fprintf(stderr, "hipFuncSetAttribute failed\n"); grid = -1; return; }
        int per_cu = 0; (void)hipOccupancyMaxActiveBlocksPerMultiprocessor(&per_cu, (const void*)mega_fwd, NTHREADS, LDS_BYTES); (void)hipGetLastError();
        grid = (per_cu >= 1) ? cus : -1;
        if (grid > 256) grid = 256;
    }
    if (grid <= 0) return;
    mega_fwd<<<grid, NTHREADS, LDS_BYTES, stream>>>(a);
#else
    launch_ph<-1>(a, stream);
    for (int l = 0; l < DEPTH; ++l) { a.layer = l;
        launch_ph<0>(a, stream); launch_ph<1>(a, stream); launch_ph<2>(a, stream); launch_ph<3>(a, stream); launch_ph<4>(a, stream); launch_ph<5>(a, stream);
        launch_ph<6>(a, stream); launch_ph<7>(a, stream); launch_ph<8>(a, stream); launch_ph<9>(a, stream); launch_ph<10>(a, stream); launch_ph<11>(a, stream);
        launch_ph<12>(a, stream); launch_ph<13>(a, stream); launch_ph<14>(a, stream); launch_ph<15>(a, stream); launch_ph<16>(a, stream); launch_ph<17>(a, stream); }
#endif
}
```
